# Optimizing an MI355X kernel written in HIP

```python
import jax
import jax.numpy as jnp
from jax import lax
import numpy as np

D_MODEL = 2048
BATCH = 8
SEQ = 2048
DEPTH = 2

GRID_W = 64
CTX_LEN = 256
EPS = 1e-6
ROPE_THETA = 10000.0
Q_BLOCK = 128
HEAD_DIM = 128
N_Q_HEADS = 8
N_KV_HEADS = 2
GQA_GROUP = N_Q_HEADS // N_KV_HEADS
ATTN_WIDTH = N_Q_HEADS * HEAD_DIM
KV_WIDTH = N_KV_HEADS * HEAD_DIM
CONV_WIDTH = D_MODEL - ATTN_WIDTH
CONV_K = 31
IN0_SPLITS = [ATTN_WIDTH, ATTN_WIDTH + KV_WIDTH, ATTN_WIDTH + 2 * KV_WIDTH,
              ATTN_WIDTH + 2 * KV_WIDTH + CONV_WIDTH]
IN0_WIDTH = ATTN_WIDTH + 2 * KV_WIDTH + 2 * CONV_WIDTH
GQA_SCALE = HEAD_DIM ** -0.5
MLA_HEADS = 16
Q_LORA = 1536
KV_LORA = 512
NOPE_DIM = 128
ROPE_DIM = 64
V_DIM = 128
QK_DIM = NOPE_DIM + ROPE_DIM
MLA_SCALE = QK_DIM ** -0.5
N_EXPERTS = 16
D_EXPERT = 1024
EC_FACTOR = 2

kernel_name = 'hybrid_conv_gqa_mla_ec_moe_dit'


def rmsnorm(x, g):
    xf = x.astype(jnp.float32)
    y = xf * lax.rsqrt(jnp.mean(xf * xf, axis=-1, keepdims=True) + EPS)
    return (y * g.astype(jnp.float32)).astype(x.dtype)


def layernorm(x, g, b):
    xf = x.astype(jnp.float32)
    mu = jnp.mean(xf, axis=-1, keepdims=True)
    xc = xf - mu
    y = xc * lax.rsqrt(jnp.mean(xc * xc, axis=-1, keepdims=True) + EPS)
    return (y * g.astype(jnp.float32) + b.astype(jnp.float32)).astype(x.dtype)


def modulate(h, shift, scale):
    return h * (1 + scale) + shift


def ada_params(cond, w, b):
    return jnp.split(jax.nn.silu(cond) @ w + b, 6, axis=-1)


def axial_rope_tables(n_tokens, d_rot):
    rows = n_tokens // GRID_W
    row = jnp.repeat(jnp.arange(rows, dtype=jnp.float32), GRID_W)
    col = jnp.tile(jnp.arange(GRID_W, dtype=jnp.float32), rows)
    n_axis = d_rot // 4
    inv_freq = ROPE_THETA ** (-jnp.arange(n_axis, dtype=jnp.float32) / n_axis)
    ang = jnp.concatenate([row[:, None] * inv_freq, col[:, None] * inv_freq], axis=-1)
    return jnp.cos(ang), jnp.sin(ang)


def apply_rope(x, cos, sin):
    half = x.shape[-1] // 2
    x1, x2 = x[..., :half], x[..., half:]
    c = cos[None, :, None, :].astype(x.dtype)
    s = sin[None, :, None, :].astype(x.dtype)
    return jnp.concatenate([x1 * c - x2 * s, x1 * s + x2 * c], axis=-1)


def sdpa(q, k, v, scale):
    s = jnp.einsum('bqhgd,bkhd->bhgqk', q, k).astype(jnp.float32) * scale
    p = jax.nn.softmax(s, axis=-1).astype(v.dtype)
    return jnp.einsum('bhgqk,bkhd->bqhgd', p, v)


def attend_latent(q_lat, k_lat, v_lat, k_ctx, v_ctx, scale):
    b, s = q_lat.shape[:2]
    keys = jnp.concatenate([k_ctx, k_lat], axis=1)
    vals = jnp.concatenate([v_ctx, v_lat], axis=1)
    nb = s // Q_BLOCK
    qb = jnp.moveaxis(q_lat.reshape((b, nb, Q_BLOCK) + q_lat.shape[2:]), 1, 0)
    ob = lax.map(lambda qq: sdpa(qq, keys, vals, scale), qb)
    return jnp.moveaxis(ob, 0, 1).reshape(b, s, -1)


def depthwise_conv(x, w, b):
    y = lax.conv_general_dilated(x, w.astype(x.dtype), window_strides=(1,),
                                 padding=[(CONV_K // 2, CONV_K // 2)],
                                 dimension_numbers=('NWC', 'WIO', 'NWC'),
                                 feature_group_count=x.shape[-1])
    return y + b


def conformer_branch(u, dw_w, dw_b, ln_g, ln_b):
    return jax.nn.silu(layernorm(depthwise_conv(u, dw_w, dw_b), ln_g, ln_b))


def mixer_ab(h_lat, h_ctx, need_ctx, w_in, q_norm_g, k_norm_g, dw_w, dw_b, ln_g, ln_b, w_out):
    cos, sin = axial_rope_tables(h_lat.shape[1], HEAD_DIM)

    def project(h, rope):
        b, l, _ = h.shape
        q, k, v, u, gt = jnp.split(h @ w_in, IN0_SPLITS, axis=-1)
        q = rmsnorm(q.reshape(b, l, N_Q_HEADS, HEAD_DIM), q_norm_g)
        k = rmsnorm(k.reshape(b, l, N_KV_HEADS, HEAD_DIM), k_norm_g)
        v = v.reshape(b, l, N_KV_HEADS, HEAD_DIM)
        if rope:
            q = apply_rope(q, cos, sin)
            k = apply_rope(k, cos, sin)
        q = q.reshape(b, l, N_KV_HEADS, GQA_GROUP, HEAD_DIM)
        return q, k, v, u * jax.nn.sigmoid(gt)

    q_l, k_l, v_l, u_l = project(h_lat, True)
    q_c, k_c, v_c, u_c = project(h_ctx, False)
    a_lat = attend_latent(q_l, k_l, v_l, k_c, v_c, GQA_SCALE)
    c_lat = conformer_branch(u_l, dw_w, dw_b, ln_g, ln_b)
    out_lat = jnp.concatenate([a_lat, c_lat], axis=-1) @ w_out
    out_ctx = None
    if need_ctx:
        b, l = h_ctx.shape[:2]
        a_ctx = sdpa(q_c, k_c, v_c, GQA_SCALE).reshape(b, l, -1)
        c_ctx_br = conformer_branch(u_c, dw_w, dw_b, ln_g, ln_b)
        out_ctx = jnp.concatenate([a_ctx, c_ctx_br], axis=-1) @ w_out
    return out_lat, out_ctx


def mixer_mla(h_lat, h_ctx, need_ctx, w_dqkv, q_lora_g, w_uq, kv_lora_g, w_ukv, w_out):
    cos, sin = axial_rope_tables(h_lat.shape[1], ROPE_DIM)

    def queries(h, rope):
        b, l, _ = h.shape
        cq = rmsnorm(h @ w_dqkv[:, :Q_LORA], q_lora_g)
        q = (cq @ w_uq).reshape(b, l, MLA_HEADS, QK_DIM)
        q_nope, q_pe = q[..., :NOPE_DIM], q[..., NOPE_DIM:]
        if rope:
            q_pe = apply_rope(q_pe, cos, sin)
        return jnp.concatenate([q_nope, q_pe], axis=-1)[:, :, :, None, :]

    def keys_values(h, rope):
        b, l, _ = h.shape
        z = h @ w_dqkv[:, Q_LORA:]
        ckv, k_pe = z[..., :KV_LORA], z[..., KV_LORA:]
        kv = (rmsnorm(ckv, kv_lora_g) @ w_ukv).reshape(b, l, MLA_HEADS, NOPE_DIM + V_DIM)
        k_nope, v = kv[..., :NOPE_DIM], kv[..., NOPE_DIM:]
        k_pe = k_pe[:, :, None, :]
        if rope:
            k_pe = apply_rope(k_pe, cos, sin)
        k = jnp.concatenate([k_nope, jnp.broadcast_to(k_pe, (b, l, MLA_HEADS, ROPE_DIM))], axis=-1)
        return k, v

    k_l, v_l = keys_values(h_lat, True)
    k_c, v_c = keys_values(h_ctx, False)
    out_lat = attend_latent(queries(h_lat, True), k_l, v_l, k_c, v_c, MLA_SCALE) @ w_out
    out_ctx = None
    if need_ctx:
        b, l = h_ctx.shape[:2]
        out_ctx = sdpa(queries(h_ctx, False), k_c, v_c, MLA_SCALE).reshape(b, l, -1) @ w_out
    return out_lat, out_ctx


def ec_moe(h, router, w_gate, w_up, w_down):
    n, d = h.shape[1], h.shape[2]
    cap = EC_FACTOR * n // N_EXPERTS
    aff = jax.nn.softmax((h @ router).astype(jnp.float32), axis=-1)
    gate, idx = lax.top_k(jnp.swapaxes(aff, 1, 2), cap)
    xs = jax.vmap(lambda hb, ib: hb[ib])(h, idx)
    hid = jax.nn.silu(jnp.einsum('becd,edf->becf', xs, w_gate)) * jnp.einsum('becd,edf->becf', xs, w_up)
    out = jnp.einsum('becf,efd->becd', hid, w_down) * gate[..., None].astype(h.dtype)
    return jax.vmap(lambda ob, ib: jnp.zeros((n, d), h.dtype).at[ib.reshape(-1)].add(ob.reshape(-1, d)))(out, idx)


def setup_inputs(seed: int = 0) -> dict:
    key = jax.random.key(seed)
    ks = iter(jax.random.split(key, 64))
    f32 = jnp.float32

    def w(shape, fan_in, mult=1.0):
        return jax.random.normal(next(ks), shape, f32) * (mult * fan_in ** -0.5)

    def gain(shape):
        return 1.0 + 0.02 * jax.random.normal(next(ks), shape, f32)

    def bias(shape):
        return 0.01 * jax.random.normal(next(ks), shape, f32)

    D, E, F = D_MODEL, N_EXPERTS, D_EXPERT
    return {
        'x': jax.random.normal(next(ks), (BATCH, SEQ, D), f32),
        'c': jax.random.normal(next(ks), (BATCH, D), f32),
        'ctx': jax.random.normal(next(ks), (BATCH, CTX_LEN, D), f32),
        'c_ctx': jax.random.normal(next(ks), (D,), f32),
        'l0_mod_w': w((D, 6 * D), D, 0.5),
        'l0_mod_b': bias((6 * D,)),
        'l0_norm1_g': gain((D,)),
        'l0_w_in': w((D, IN0_WIDTH), D),
        'l0_q_norm_g': gain((HEAD_DIM,)),
        'l0_k_norm_g': gain((HEAD_DIM,)),
        'l0_dw_w': w((CONV_K, 1, CONV_WIDTH), CONV_K),
        'l0_dw_b': bias((CONV_WIDTH,)),
        'l0_conv_ln_g': gain((CONV_WIDTH,)),
        'l0_conv_ln_b': bias((CONV_WIDTH,)),
        'l0_w_out': w((D, D), D),
        'l0_norm2_g': gain((D,)),
        'l0_router': w((D, E), D),
        'l0_w_gate': w((E, D, F), D),
        'l0_w_up': w((E, D, F), D),
        'l0_w_down': w((E, F, D), F),
        'l1_mod_w': w((D, 6 * D), D, 0.5),
        'l1_mod_b': bias((6 * D,)),
        'l1_norm1_g': gain((D,)),
        'l1_w_dqkv': w((D, Q_LORA + KV_LORA + ROPE_DIM), D),
        'l1_q_lora_norm_g': gain((Q_LORA,)),
        'l1_w_uq': w((Q_LORA, MLA_HEADS * QK_DIM), Q_LORA),
        'l1_kv_lora_norm_g': gain((KV_LORA,)),
        'l1_w_ukv': w((KV_LORA, MLA_HEADS * (NOPE_DIM + V_DIM)), KV_LORA),
        'l1_w_out': w((MLA_HEADS * V_DIM, D), MLA_HEADS * V_DIM),
        'l1_norm2_g': gain((D,)),
        'l1_router': w((D, E), D),
        'l1_w_gate': w((E, D, F), D),
        'l1_w_up': w((E, D, F), D),
        'l1_w_down': w((E, F, D), F),
        'final_norm_g': gain((D,)),
    }


def reference(x, c, ctx, c_ctx,
              l0_mod_w, l0_mod_b, l0_norm1_g, l0_w_in, l0_q_norm_g, l0_k_norm_g, l0_dw_w, l0_dw_b,
              l0_conv_ln_g, l0_conv_ln_b, l0_w_out, l0_norm2_g, l0_router, l0_w_gate, l0_w_up, l0_w_down,
              l1_mod_w, l1_mod_b, l1_norm1_g, l1_w_dqkv, l1_q_lora_norm_g, l1_w_uq, l1_kv_lora_norm_g,
              l1_w_ukv, l1_w_out, l1_norm2_g, l1_router, l1_w_gate, l1_w_up, l1_w_down,
              final_norm_g):
    layers = [
        (mixer_ab, (l0_w_in, l0_q_norm_g, l0_k_norm_g, l0_dw_w, l0_dw_b, l0_conv_ln_g, l0_conv_ln_b, l0_w_out),
         (l0_mod_w, l0_mod_b, l0_norm1_g, l0_norm2_g, l0_router, l0_w_gate, l0_w_up, l0_w_down)),
        (mixer_mla, (l1_w_dqkv, l1_q_lora_norm_g, l1_w_uq, l1_kv_lora_norm_g, l1_w_ukv, l1_w_out),
         (l1_mod_w, l1_mod_b, l1_norm1_g, l1_norm2_g, l1_router, l1_w_gate, l1_w_up, l1_w_down)),
    ]
    xc = ctx
    for i in range(DEPTH):
        mixer, mix_p, (mod_w, mod_b, g1, g2, router, wg, wu, wd) = layers[i]
        need_ctx = i < DEPTH - 1
        sh1, sc1, ga1, sh2, sc2, ga2 = [m[:, None, :] for m in ada_params(c, mod_w, mod_b)]
        csh1, csc1, cga1, csh2, csc2, cga2 = ada_params(c_ctx, mod_w, mod_b)
        h_lat = modulate(rmsnorm(x, g1), sh1, sc1)
        h_ctx = modulate(rmsnorm(xc, g1), csh1, csc1)
        m_lat, m_ctx = mixer(h_lat, h_ctx, need_ctx, *mix_p)
        x = x + ga1 * m_lat
        x = x + ga2 * ec_moe(modulate(rmsnorm(x, g2), sh2, sc2), router, wg, wu, wd)
        if need_ctx:
            xc = xc + cga1 * m_ctx
            xc = xc + cga2 * ec_moe(modulate(rmsnorm(xc, g2), csh2, csc2), router, wg, wu, wd)
    return rmsnorm(x, final_norm_g)
```

```cpp
#include <hip/hip_runtime.h>
#include <cstdio>
#include <cstdint>

#ifndef MK_MULTI
#define MK_MULTI 0
#endif

#define LAS __attribute__((address_space(3)))
typedef unsigned short bf16_t;
typedef short bf16x8 __attribute__((ext_vector_type(8)));
typedef short s16x4 __attribute__((ext_vector_type(4)));
typedef float f32x4 __attribute__((ext_vector_type(4)));
typedef float f32x2 __attribute__((ext_vector_type(2)));
typedef float f32x16 __attribute__((ext_vector_type(16)));
typedef unsigned u32x4 __attribute__((ext_vector_type(4)));
typedef unsigned u32x2 __attribute__((ext_vector_type(2)));
typedef int v8i __attribute__((ext_vector_type(8)));
typedef int v4i __attribute__((ext_vector_type(4)));

constexpr int D = 2048, NB = 8, SEQ = 2048, CL = 256, RPB = SEQ + CL, M = NB * RPB, MT = M / 256;
constexpr int NE = 16, DF = 1024;
constexpr int IN0W = 3584, QKVW = 1536, ZW = 2304, QLORA = 1536, KVLORA = 512, QW = 3072, KVW = 4096;
constexpr int NTHR = 512;
constexpr int LDS_BYTES = 147456, IDX_OFF = 131072, MISC_OFF = 131072 + 8192;
constexpr float EPS = 1e-6f;
constexpr int NPH = 22;

constexpr size_t al256(size_t x) { return (x + 255) / 256 * 256; }
constexpr size_t WS_CTL = 0, CTL_BYTES = 65536;
constexpr size_t WS_MODP = WS_CTL + CTL_BYTES;
constexpr size_t WS_MOD = WS_MODP + al256((size_t)2 * 32 * 9 * 12288 * 4);
constexpr size_t WS_ROPE = WS_MOD + al256((size_t)2 * 9 * 12288 * 4);
constexpr size_t WS_AFF = WS_ROPE + al256((size_t)2048 * 192 * 4);
constexpr size_t WS_TOKSLOT = WS_AFF + al256((size_t)M * 16 * 4);
constexpr size_t WS_ROWIDX = WS_TOKSLOT + al256((size_t)M * 16 * 4);
constexpr size_t WS_GATE = WS_ROWIDX + al256((size_t)16 * 2304 * 4);
constexpr size_t WS_RSTDQ = WS_GATE + al256((size_t)16 * 2304 * 4);
constexpr size_t WS_RSTDKV = WS_RSTDQ + al256((size_t)M * 4);
constexpr size_t WS_KPE = WS_RSTDKV + al256((size_t)M * 4);
constexpr size_t WS_K8G = WS_KPE + al256((size_t)M * 64 * 2);
constexpr size_t WS_K8N = WS_K8G + al256((size_t)M * 256);
constexpr size_t WS_VT8G = WS_K8N + al256((size_t)M * 2048);
constexpr size_t WS_VT8N = WS_VT8G + al256((size_t)NB * 2 * 128 * RPB);
constexpr size_t WS_XRES = WS_VT8N + al256((size_t)NB * 16 * 128 * RPB);
constexpr size_t WS_H = WS_XRES + al256((size_t)M * D * 4);
constexpr size_t WS_R3 = WS_H + al256((size_t)M * D * 2);
constexpr size_t R3_PROJ = 0, R3_UG = (size_t)M * IN0W * 2, R3_Z = 0, R3_Q1 = (size_t)M * ZW * 2;
constexpr size_t R3_BYTES = ((size_t)M * ZW * 2 + (size_t)NB * SEQ * QW * 2) > ((size_t)M * IN0W * 2 + (size_t)M * 1024 * 2) ? ((size_t)M * ZW * 2 + (size_t)NB * SEQ * QW * 2) : ((size_t)M * IN0W * 2 + (size_t)M * 1024 * 2);
constexpr size_t WS_CAT = WS_R3 + al256(R3_BYTES);
constexpr size_t WS_Y = WS_CAT + al256((size_t)M * D * 2);
constexpr size_t WS_W = WS_Y + al256((size_t)M * KVW * 2);
constexpr size_t W_IN0 = 0;
constexpr size_t W_OUT0 = W_IN0 + (size_t)IN0W * D;
constexpr size_t W_GU0 = W_OUT0 + (size_t)D * D;
constexpr size_t W_DN0 = W_GU0 + (size_t)NE * 2048 * D;
constexpr size_t W_DQKV = W_DN0 + (size_t)NE * D * DF;
constexpr size_t W_UQ = W_DQKV + (size_t)ZW * D;
constexpr size_t W_UKV = W_UQ + (size_t)QW * QLORA;
constexpr size_t W_OUT1 = W_UKV + (size_t)KVW * KVLORA;
constexpr size_t W_GU1 = W_OUT1 + (size_t)D * D;
constexpr size_t W_DN1 = W_GU1 + (size_t)NE * 2048 * D;
constexpr size_t W_END = W_DN1 + (size_t)NE * D * DF;
constexpr size_t WS_END = WS_W + W_END * 2;

struct Params { const float* in[35]; float* out; unsigned char* ws; int ph_lo, ph_hi; };

__device__ __forceinline__ f32x4 bf4_to_f32(u32x2 w) { return (f32x4){__uint_as_float(w.x << 16), __uint_as_float(w.x & 0xffff0000u), __uint_as_float(w.y << 16), __uint_as_float(w.y & 0xffff0000u)}; }
__device__ __forceinline__ unsigned cvt4_fp8_pl(float a, float b, float c, float d) { unsigned w; asm("v_cvt_pk_fp8_f32 %0, %1, %2\n\tv_cvt_pk_fp8_f32 %0, %3, %4 op_sel:[0,0,1]\n\ts_nop 1" : "=&v"(w) : "v"(a), "v"(b), "v"(c), "v"(d)); return w; }
__device__ __forceinline__ unsigned cvt_pk_bf16(float lo, float hi) { unsigned r; asm("v_cvt_pk_bf16_f32 %0, %1, %2" : "=v"(r) : "v"(lo), "v"(hi)); return r; }
__device__ __forceinline__ unsigned cvt4_fp8(float a, float b, float c, float d) { unsigned w; asm("v_cvt_pk_fp8_f32 %0, %1, %2\n\tv_cvt_pk_fp8_f32 %0, %3, %4 op_sel:[0,0,1]" : "=&v"(w) : "v"(a), "v"(b), "v"(c), "v"(d)); return w; }
__device__ __forceinline__ float bf_lo(unsigned w) { return __uint_as_float(w << 16); }
__device__ __forceinline__ float bf_hi(unsigned w) { return __uint_as_float(w & 0xffff0000u); }
__device__ __forceinline__ float bf2f(bf16_t h) { return __uint_as_float(((unsigned)h) << 16); }
__device__ __forceinline__ float wave_sum(float v) {
#pragma unroll
    for (int o = 32; o; o >>= 1) v += __shfl_xor(v, o);
    return v;
}
__device__ __forceinline__ int lane_id() { int r; asm volatile("v_mbcnt_lo_u32_b32 %0, -1, 0\n\tv_mbcnt_hi_u32_b32 %0, -1, %0" : "=v"(r)); return r; }
#define TID_OF(wv) ((wv) * 64 + lane_id())
__device__ __forceinline__ int key_slot(int k) { const int g = k & 31; return (k & ~31) | (((g & 3) + 4 * (g >> 3)) + 16 * ((g >> 2) & 1)); }
__device__ __forceinline__ float silu_f(float x) { return x * __builtin_amdgcn_rcpf(1.f + __builtin_amdgcn_exp2f(-1.4426950408889634f * x)); }
__device__ __forceinline__ float sigmoid_f(float x) { return __builtin_amdgcn_rcpf(1.f + __builtin_amdgcn_exp2f(-1.4426950408889634f * x)); }

#define XB_TMO      128
#define XB_XCNT(j)  (256  + 64 * (j))
#define XB_XSUB(j)  (1280 + 64 * (j))
#define XB_XGEN(j)  (2304 + 64 * (j))
#define XB_TOP      3328
#define XB_TOPGEN   3392
#define XCD_BAR_WORDS 3456
#define XB_SPIN_CAP (1u << 18)

__device__ __forceinline__ unsigned xb_ld(unsigned* p)              { return __hip_atomic_load(p, __ATOMIC_RELAXED, __HIP_MEMORY_SCOPE_AGENT); }
__device__ __forceinline__ unsigned xb_add(unsigned* p, unsigned v) { return __hip_atomic_fetch_add(p, v, __ATOMIC_RELAXED, __HIP_MEMORY_SCOPE_AGENT); }
__device__ __forceinline__ unsigned xb_xcc_id() { return (unsigned)__builtin_amdgcn_s_getreg((3 << 11) | 20) & 0xFu; }
#define XB_SPIN(cond, bar) do { unsigned _sp = 0; while (cond) { __builtin_amdgcn_s_sleep(1); \
    if ((++_sp & 255u) == 0u) { if (xb_ld(&(bar)[XB_TMO])) break; if (_sp > XB_SPIN_CAP) { atomicAdd(&(bar)[XB_TMO], 1u); break; } } } } while (0)

struct XcdBarrier { unsigned* bar; unsigned x; volatile LAS unsigned* st; };

__device__ __forceinline__ XcdBarrier xcd_barrier_post(unsigned* bar, volatile LAS unsigned* st, int wv) {
    XcdBarrier b; b.bar = bar; b.x = xb_xcc_id(); b.st = st;
    if (wv == 0 && lane_id() == 0) (void)xb_add(&bar[XB_XCNT(b.x)], 1u);
    return b;
}
__device__ __forceinline__ void xcd_barrier_complete(unsigned* bar, unsigned x, unsigned& nloc, unsigned& nx) {
    const unsigned G = gridDim.x * gridDim.y * gridDim.z;
    unsigned sum, cnt, mine, sp = 0u;
    for (;;) {
        sum = 0u; cnt = 0u; mine = 0u;
#pragma unroll
        for (unsigned j = 0; j < 16; ++j) { const unsigned c = xb_ld(&bar[XB_XCNT(j)]); sum += c; cnt += (c > 0u) ? 1u : 0u; mine = (j == x) ? c : mine; }
        if (sum == G) break;
        __builtin_amdgcn_s_sleep(1);
        if ((++sp & 255u) == 0u) { if (xb_ld(&bar[XB_TMO])) break; if (sp > XB_SPIN_CAP) { atomicAdd(&bar[XB_TMO], 1u); break; } }
    }
    nloc = mine > 0u ? mine : 1u; nx = cnt > 0u ? cnt : 1u;
}
__device__ __forceinline__ void xcd_barrier(const XcdBarrier& b, int wv) {
    asm volatile("s_waitcnt vmcnt(0)" ::: "memory");
    __syncthreads();
    if (wv == 0 && lane_id() == 0) {
        unsigned* bar = b.bar;
        __builtin_amdgcn_s_waitcnt(0);
        unsigned nloc = b.st[0], nx = b.st[1];
        if (nloc == 0u) { xcd_barrier_complete(bar, b.x, nloc, nx); b.st[0] = nloc; b.st[1] = nx; }
        const unsigned old = xb_add(&bar[XB_XSUB(b.x)], 1u);
        const unsigned gen = old / nloc;
        if (old + 1u == (gen + 1u) * nloc) {
            __builtin_amdgcn_fence(__ATOMIC_RELEASE, "agent");
            asm volatile("s_waitcnt vmcnt(0)" ::: "memory");
            const unsigned og = xb_add(&bar[XB_TOP], 1u);
            const unsigned tg = og / nx;
            if (og + 1u == (tg + 1u) * nx) xb_add(&bar[XB_TOPGEN], 1u);
            else XB_SPIN(xb_ld(&bar[XB_TOPGEN]) == tg, bar);
            __builtin_amdgcn_fence(__ATOMIC_ACQUIRE, "agent");
            xb_add(&bar[XB_XGEN(b.x)], 1u);
            asm volatile("s_waitcnt vmcnt(0)" ::: "memory");
        } else {
            XB_SPIN(xb_ld(&bar[XB_XGEN(b.x)]) == gen, bar);
            __builtin_amdgcn_fence(__ATOMIC_ACQUIRE, "agent");
            asm volatile("s_waitcnt vmcnt(0)" ::: "memory");
        }
    }
    __syncthreads();
}

namespace gm {
constexpr int BM = 256, BK = 64, HALF = 128, HTB = HALF * BK * 2, STAGE_BYTES = 8 * HTB, NXCD = 8, WGM = 6;
__host__ __device__ __forceinline__ int lds_byte(int r, int c) { const int st = (r >> 4) * 2 + (c >> 5), rr = r & 15, cc = c & 31, ob = rr * 64 + cc * 2; return st * 1024 + (ob ^ (((ob >> 9) & 1) << 5)); }
__host__ __device__ __forceinline__ void stage_rc(int b, int& R, int& C) { const int st = b / 1024, sb = b % 1024, swz = sb ^ (((sb >> 9) & 1) << 5); R = (st >> 1) * 16 + swz / 64; C = (st & 1) * 32 + (swz % 64) / 2; }
__host__ __device__ __forceinline__ int perm32(int rho) { const int n = rho >> 4, i = rho & 15; return 8 * (i >> 2) + 4 * n + (i & 3); }

struct Unit { int pm, pn, g; };

struct Sched {
    int nMv, nN, nwg, G, c, mode, tpg;
    __device__ void init(int nMv_, int nN_, int G_, int c_, int mode_, int tpg_) { nMv = nMv_; nN = nN_; nwg = nMv_ * nN_; G = G_; c = c_; mode = mode_; tpg = tpg_; }
    __device__ bool next(int i, Unit& u) const {
        const long L = (long)i * G + c; if (L >= nwg) return false;
        int wgid = (int)L; { const int q = nwg / NXCD, r = nwg % NXCD, xcd = wgid % NXCD, off = wgid / NXCD; wgid = (xcd < r ? xcd * (q + 1) : r * (q + 1) + (xcd - r) * q) + off; }
        const int nig = WGM * nN, gid = wgid / nig, fm = gid * WGM, gsz = (nMv - fm) < WGM ? (nMv - fm) : WGM;
        const int v = fm + ((wgid % nig) % gsz); u.pn = (wgid % nig) / gsz;
        if (mode == 0) { u.pm = v; u.g = 0; }
        else if (mode == 1) { u.pm = (v >> 3) * 9 + 1 + (v & 7); u.g = 0; }
        else { u.g = v / tpg; u.pm = v - u.g * tpg; }
        return true;
    }
};

struct EpiStoreBf16 {
    static constexpr bool PERM = true, SWAPV = false;
    bf16_t* O; int ldo; const float* rs; int rowmode;
    __device__ __forceinline__ void operator()(const f32x4 (&acc)[2][2][4][2], const Unit& u, int wr, int wc, int fr, int fq) const {
        const int urow0 = u.pm * 256 + wr * 64 + fr;
        int orow0 = urow0;
        if (rowmode == 1) { const int b = u.pm / 9, o = u.pm - b * 9; orow0 = b * 2048 + (o - 1) * 256 + wr * 64 + fr; }
        const int col0 = u.pn * 256 + wc * 32 + 8 * fq;
        float scv[8];
#pragma unroll
        for (int k = 0; k < 8; ++k) scv[k] = rs ? rs[urow0 + (k >> 2) * 128 + (k & 3) * 16] : 1.f;
#pragma unroll
        for (int ai = 0; ai < 2; ++ai)
#pragma unroll
            for (int m = 0; m < 4; ++m) {
                const int rr = ai * 128 + m * 16; const float sc = scv[ai * 4 + m]; bf16_t* rowp = O + (size_t)(orow0 + rr) * ldo + col0;
#pragma unroll
                for (int bj = 0; bj < 2; ++bj) { const f32x4 v0 = acc[ai][bj][m][0] * sc, v1 = acc[ai][bj][m][1] * sc;
                    u32x4 w; w.x = cvt_pk_bf16(v0[0], v0[1]); w.y = cvt_pk_bf16(v0[2], v0[3]); w.z = cvt_pk_bf16(v1[0], v1[1]); w.w = cvt_pk_bf16(v1[2], v1[3]);
                    *(u32x4*)(rowp + bj * 128) = w; }
            }
    }
};
struct EpiKV {
    static constexpr bool PERM = true, SWAPV = true;
    unsigned char* vt8; unsigned char* k8; const float* rs;
    __device__ __forceinline__ void operator()(const f32x4 (&acc)[2][2][4][2], const Unit& u, int wr, int wc, int fr, int fq) const {
        const int row0 = u.pm * 256 + wr * 64 + fr, c0 = wc * 32 + 8 * fq, b = u.pm / 9, kb = (u.pm - b * 9) * 256;
        float scv[8]; f32x4 sc4a[2][4];
#pragma unroll
        for (int k = 0; k < 8; ++k) scv[k] = rs[row0 + (k >> 2) * 128 + (k & 3) * 16];
#pragma unroll
        for (int ai = 0; ai < 2; ++ai)
#pragma unroll
            for (int m = 0; m < 4; ++m) sc4a[ai][m] = *(const f32x4*)(rs + u.pm * 256 + ai * 128 + wr * 64 + 4 * fq + 16 * m);
#pragma unroll
        for (int ai = 0; ai < 2; ++ai)
#pragma unroll
            for (int m = 0; m < 4; ++m) {
                const int row = row0 + ai * 128 + m * 16; const float sc = scv[ai * 4 + m];
                const f32x4 v0 = acc[ai][0][m][0] * sc, v1 = acc[ai][0][m][1] * sc; u32x2 w; w.x = cvt4_fp8(v0[0], v0[1], v0[2], v0[3]); w.y = cvt4_fp8(v1[0], v1[1], v1[2], v1[3]);
                *(u32x2*)(k8 + (size_t)row * 2048 + u.pn * 128 + c0) = w;
            }
#pragma unroll
        for (int ai = 0; ai < 2; ++ai) {
#pragma unroll
            for (int n = 0; n < 2; ++n) {
                unsigned W[4];
#pragma unroll
                for (int m = 0; m < 4; ++m) { const f32x4 v = acc[ai][1][m][n] * sc4a[ai][m]; W[m] = cvt4_fp8_pl(v[0], v[1], v[2], v[3]); }
                const auto p0 = __builtin_amdgcn_permlane32_swap(W[0], W[1], false, false), p1 = __builtin_amdgcn_permlane32_swap(W[2], W[3], false, false);
                const auto q0 = __builtin_amdgcn_permlane32_swap(p0[0], p1[0], false, false), q1 = __builtin_amdgcn_permlane32_swap(p0[1], p1[1], false, false);
                const u32x4 w = {q0[0], q1[0], q0[1], q1[1]};
                const int ch = wc * 32 + 8 * (fr >> 2) + 4 * n + (fr & 3);
                *(u32x4*)(vt8 + ((size_t)(b * 16 + u.pn) * 128 + ch) * RPB + kb + ai * 128 + wr * 64 + 16 * (fq & 1) + 32 * (fq >> 1)) = w;
            }
        }
    }
};
struct EpiStoreF8 {
    static constexpr bool PERM = true, SWAPV = false;
    unsigned char* O; int ldo;
    __device__ __forceinline__ void operator()(const f32x4 (&acc)[2][2][4][2], const Unit& u, int wr, int wc, int fr, int fq) const {
        const int row0 = u.pm * 256 + wr * 64 + fr, col0 = u.pn * 256 + wc * 32 + 8 * fq;
#pragma unroll
        for (int ai = 0; ai < 2; ++ai)
#pragma unroll
            for (int m = 0; m < 4; ++m) {
                unsigned char* rowp = O + (size_t)(row0 + ai * 128 + m * 16) * ldo + col0;
#pragma unroll
                for (int bj = 0; bj < 2; ++bj) { const f32x4 v0 = acc[ai][bj][m][0], v1 = acc[ai][bj][m][1];
                    u32x2 w; w.x = cvt4_fp8(v0[0], v0[1], v0[2], v0[3]); w.y = cvt4_fp8(v1[0], v1[1], v1[2], v1[3]); *(u32x2*)(rowp + bj * 128) = w; }
            }
    }
};
struct EpiInProj {
    static constexpr bool PERM = true, SWAPV = false;
    bf16_t* qkv; bf16_t* ug; unsigned char* vt8;
    __device__ __forceinline__ void operator()(const f32x4 (&acc)[2][2][4][2], const Unit& u, int wr, int wc, int fr, int fq) const {
        const int row0 = u.pm * 256 + wr * 64 + fr;
        if (u.pn < 6) {
            const int col0 = u.pn * 256 + wc * 32 + 8 * fq;
#pragma unroll
            for (int ai = 0; ai < 2; ++ai)
#pragma unroll
                for (int m = 0; m < 4; ++m) { bf16_t* rowp = qkv + (size_t)(row0 + ai * 128 + m * 16) * QKVW + col0;
#pragma unroll
                    for (int bj = 0; bj < 2; ++bj) { const f32x4 v0 = acc[ai][bj][m][0], v1 = acc[ai][bj][m][1];
                        u32x4 w; w.x = cvt_pk_bf16(v0[0], v0[1]); w.y = cvt_pk_bf16(v0[2], v0[3]); w.z = cvt_pk_bf16(v1[0], v1[1]); w.w = cvt_pk_bf16(v1[2], v1[3]);
                        *(u32x4*)(rowp + bj * 128) = w; } }
            if (u.pn == 5) {
                const int b = u.pm / 9, key0 = (u.pm - b * 9) * 256 + wr * 64 + fr;
#pragma unroll
                for (int ai = 0; ai < 2; ++ai)
#pragma unroll
                    for (int m = 0; m < 4; ++m) { const int ks = key_slot(key0 + ai * 128 + m * 16);
#pragma unroll
                        for (int bj = 0; bj < 2; ++bj) { unsigned char* vp = vt8 + ((size_t)(b * 2 + bj) * 128 + wc * 32 + 8 * fq) * RPB + ks;
#pragma unroll
                            for (int n = 0; n < 2; ++n) { const unsigned w = cvt4_fp8(acc[ai][bj][m][n][0], acc[ai][bj][m][n][1], acc[ai][bj][m][n][2], acc[ai][bj][m][n][3]);
#pragma unroll
                                for (int j = 0; j < 4; ++j) vp[(size_t)(4 * n + j) * RPB] = (unsigned char)((w >> (8 * j)) & 0xffu); } } }
            }
        } else {
            const int col0 = (u.pn - 6) * 128 + wc * 32 + 8 * fq;
#pragma unroll
            for (int ai = 0; ai < 2; ++ai)
#pragma unroll
                for (int m = 0; m < 4; ++m) { bf16_t* rowp = ug + (size_t)(row0 + ai * 128 + m * 16) * 1024 + col0;
                    float h[8];
#pragma unroll
                    for (int n = 0; n < 2; ++n)
#pragma unroll
                        for (int j = 0; j < 4; ++j) h[n * 4 + j] = acc[ai][0][m][n][j] * sigmoid_f(acc[ai][1][m][n][j]);
                    u32x4 w; w.x = cvt_pk_bf16(h[0], h[1]); w.y = cvt_pk_bf16(h[2], h[3]); w.z = cvt_pk_bf16(h[4], h[5]); w.w = cvt_pk_bf16(h[6], h[7]);
                    *(u32x4*)rowp = w; }
        }
    }
};
struct EpiResid {
    static constexpr bool PERM = true, SWAPV = false;
    const float* xin; const float* cin; const bf16_t* xsrc; bf16_t* xres; const float* ga;
    __device__ __forceinline__ void operator()(const f32x4 (&acc)[2][2][4][2], const Unit& u, int wr, int wc, int fr, int fq) const {
        const int b = u.pm / 9, o = u.pm - b * 9, bs = (o == 0) ? 8 : b;
        const float* srow0 = o == 0 ? cin + (size_t)(b * 256) * D : xin + (size_t)(b * 2048 + (o - 1) * 256) * D;
        const size_t prow0 = (size_t)(u.pm * 256) * D;
        const int col0 = u.pn * 256 + wc * 32 + 8 * fq;
        f32x4 gv[2][2];
#pragma unroll
        for (int bj = 0; bj < 2; ++bj)
#pragma unroll
            for (int n = 0; n < 2; ++n) gv[bj][n] = *(const f32x4*)(ga + (size_t)bs * 12288 + col0 + bj * 128 + n * 4);
#pragma unroll
        for (int ai = 0; ai < 2; ++ai)
#pragma unroll
            for (int m = 0; m < 4; ++m) {
                const size_t ro = (size_t)(wr * 64 + fr + ai * 128 + m * 16) * D + col0;
#pragma unroll
                for (int bj = 0; bj < 2; ++bj) { f32x4 s0, s1;
                    if (xsrc) { const u32x4 w = *(const u32x4*)(xsrc + prow0 + ro + bj * 128); s0 = bf4_to_f32((u32x2){w.x, w.y}); s1 = bf4_to_f32((u32x2){w.z, w.w}); }
                    else { s0 = *(const f32x4*)(srow0 + ro + bj * 128); s1 = *(const f32x4*)(srow0 + ro + bj * 128 + 4); }
                    const f32x4 v0 = s0 + gv[bj][0] * acc[ai][bj][m][0], v1 = s1 + gv[bj][1] * acc[ai][bj][m][1];
                    u32x4 w; w.x = cvt_pk_bf16(v0[0], v0[1]); w.y = cvt_pk_bf16(v0[2], v0[3]); w.z = cvt_pk_bf16(v1[0], v1[1]); w.w = cvt_pk_bf16(v1[2], v1[3]);
                    *(u32x4*)(xres + prow0 + ro + bj * 128) = w; }
            }
    }
};
struct EpiSwiglu {
    static constexpr bool PERM = true, SWAPV = false;
    unsigned char* hid; int rpg;
    __device__ __forceinline__ void operator()(const f32x4 (&acc)[2][2][4][2], const Unit& u, int wr, int wc, int fr, int fq) const {
        const int row0 = u.g * rpg + u.pm * 256 + wr * 64 + fr, col0 = u.pn * 128 + wc * 32 + 8 * fq;
#pragma unroll
        for (int ai = 0; ai < 2; ++ai)
#pragma unroll
            for (int m = 0; m < 4; ++m) {
                unsigned char* rowp = hid + (size_t)(row0 + ai * 128 + m * 16) * DF + col0;
                float h[8];
#pragma unroll
                for (int n = 0; n < 2; ++n)
#pragma unroll
                    for (int j = 0; j < 4; ++j) h[n * 4 + j] = silu_f(acc[ai][0][m][n][j]) * acc[ai][1][m][n][j];
                u32x2 w;
                w.x = cvt4_fp8(h[0], h[1], h[2], h[3]); w.y = cvt4_fp8(h[4], h[5], h[6], h[7]);
                *(u32x2*)rowp = w;
            }
    }
};
struct EpiDown {
    static constexpr bool PERM = true, SWAPV = false;
    unsigned char* y; const float* gate; int rpg;
    __device__ __forceinline__ void operator()(const f32x4 (&acc)[2][2][4][2], const Unit& u, int wr, int wc, int fr, int fq) const {
        const int row0 = u.g * rpg + u.pm * 256 + wr * 64 + fr, col0 = u.pn * 256 + wc * 32 + 8 * fq;
        float gv[8];
#pragma unroll
        for (int k = 0; k < 8; ++k) gv[k] = gate[row0 + (k >> 2) * 128 + (k & 3) * 16];
#pragma unroll
        for (int ai = 0; ai < 2; ++ai)
#pragma unroll
            for (int m = 0; m < 4; ++m) {
                const int r = row0 + ai * 128 + m * 16; const float sc = gv[ai * 4 + m] * 32.f; unsigned char* rowp = y + (size_t)r * D + col0;
#pragma unroll
                for (int bj = 0; bj < 2; ++bj) { const f32x4 v0 = acc[ai][bj][m][0] * sc, v1 = acc[ai][bj][m][1] * sc;
                    u32x2 w; w.x = cvt4_fp8(v0[0], v0[1], v0[2], v0[3]); w.y = cvt4_fp8(v1[0], v1[1], v1[2], v1[3]); *(u32x2*)(rowp + bj * 128) = w; }
            }
    }
};

template <class Epi, bool GATHER, bool F8 = false>
__device__ __forceinline__ void gemm_phase(LAS unsigned char* lds, const bf16_t* A, int lda, size_t a_gs, const bf16_t* Bt, int K, size_t b_gs,
                                           const Sched& S, const Epi& E, const int* rowidx, int rpg, int wv, int scl_a_ = 0x7F7F7F7F) {
    const int lane = lane_id(), tid = wv * 64 + lane, wid = wv, wr = wid >> 2, wc = wid & 3, fr = lane & 15, fq = lane >> 4;
    const int nt = K / BK;
    unsigned voffA[2], voffB[2]; int Rr[2], Cc[2];
#pragma unroll
    for (int i = 0; i < 2; ++i) { int R, C; stage_rc(tid * 16 + i * 8192, R, C); const int Rb = Epi::PERM ? ((R & ~31) + perm32(R & 31)) : R;
        voffA[i] = (unsigned)(R * lda + C) * 2u; voffB[i] = (unsigned)(Rb * K + C) * 2u; Rr[i] = R; Cc[i] = C; }
    const size_t kstep = (size_t)(BK * 2);
    const size_t hstepA = (size_t)HALF * lda * 2, hstepB = (size_t)HALF * K * 2;
    const size_t tstepA = 2 * hstepA, tstepB = 2 * hstepB;
    const unsigned ldsw = (unsigned)wid * 1024u;
    const int aoff = lds_byte(wr * 64 + fr, fq * 8), boff = lds_byte(wc * 32 + fr, fq * 8);
    LAS int* idx = (LAS int*)(lds + IDX_OFF);
    Unit cur, nxt; int ui = 0;
    if (!S.next(0, cur)) return;
    if constexpr (GATHER) {
        int iv[8]; bool ok[8]; Unit u = cur;
#pragma unroll
        for (int i = 0; i < 8; ++i) { Unit un; ok[i] = S.next(i, un); if (ok[i]) u = un; iv[i] = rowidx[u.g * rpg + u.pm * 256 + (tid & 255)]; }
#pragma unroll
        for (int i = 0; i < 8; ++i) if (ok[i] && tid < 256) idx[i * 256 + tid] = iv[i];
        __syncthreads();
    }
#define GM_SA(b, h) (((b) * 2 + (h)) * HTB)
#define GM_SB(b, h) ((4 + (b) * 2 + (h)) * HTB)
#define GM_LD2(bufoff, gbase, o0, o1) do { \
        __builtin_amdgcn_global_load_lds((const unsigned*)((const char*)(gbase) + (o0)), (LAS unsigned*)(lds + (bufoff) + ldsw), 16, 0, 0); \
        __builtin_amdgcn_global_load_lds((const unsigned*)((const char*)(gbase) + (o1)), (LAS unsigned*)(lds + (bufoff) + ldsw + 8192), 16, 0, 0); } while (0)
#define GM_STAGE_B(bufoff, gbase) GM_LD2(bufoff, gbase, voffB[0], voffB[1])
#define GM_STAGE_A(bufoff, kb, h, OFF) do { if constexpr (GATHER) GM_LD2(bufoff, kb, OFF[h][0], OFF[h][1]); else GM_LD2(bufoff, (kb) + (h) * hstepA, voffA[0], voffA[1]); } while (0)
#define GM_LDA(dst, b, h) do { if constexpr (F8) { _Pragma("unroll") for (int m = 0; m < 4; ++m) dst##8[m] = __builtin_shufflevector(*(const LAS v4i*)(lds + GM_SA(b, h) + aoff + m * 2048), *(const LAS v4i*)(lds + GM_SA(b, h) + aoff + m * 2048 + 1024), 0, 1, 2, 3, 4, 5, 6, 7); } \
        else { _Pragma("unroll") for (int m = 0; m < 4; ++m) _Pragma("unroll") for (int k = 0; k < 2; ++k) dst[m][k] = *(const LAS bf16x8*)(lds + GM_SA(b, h) + aoff + m * 2048 + k * 1024); } } while (0)
#define GM_LDB(dst, b, h) do { if constexpr (F8) { _Pragma("unroll") for (int n = 0; n < 2; ++n) dst##8[n] = __builtin_shufflevector(*(const LAS v4i*)(lds + GM_SB(b, h) + boff + n * 2048), *(const LAS v4i*)(lds + GM_SB(b, h) + boff + n * 2048 + 1024), 0, 1, 2, 3, 4, 5, 6, 7); } \
        else { _Pragma("unroll") for (int n = 0; n < 2; ++n) _Pragma("unroll") for (int k = 0; k < 2; ++k) dst[n][k] = *(const LAS bf16x8*)(lds + GM_SB(b, h) + boff + n * 2048 + k * 1024); } } while (0)
#define GM_MMA(ai, bj, At, Bt_) do { __builtin_amdgcn_s_setprio(1); \
        if constexpr (F8) { _Pragma("unroll") for (int m = 0; m < 4; ++m) _Pragma("unroll") for (int n = 0; n < 2; ++n) { \
            if constexpr (Epi::SWAPV && (bj) == 1) asm volatile("v_mfma_scale_f32_16x16x128_f8f6f4 %0, %1, %2, %0, %3, %4 op_sel_hi:[0,0,0]" : "+v"(acc[ai][bj][m][n]) : "v"(At##8[m]), "v"(Bt_##8[n]), "v"(scl_a), "v"(scl_w)); \
            else asm volatile("v_mfma_scale_f32_16x16x128_f8f6f4 %0, %1, %2, %0, %3, %4 op_sel_hi:[0,0,0]" : "+v"(acc[ai][bj][m][n]) : "v"(Bt_##8[n]), "v"(At##8[m]), "v"(scl_w), "v"(scl_a)); } } \
        else { _Pragma("unroll") for (int m = 0; m < 4; ++m) _Pragma("unroll") for (int n = 0; n < 2; ++n) _Pragma("unroll") for (int k = 0; k < 2; ++k) \
            acc[ai][bj][m][n] = __builtin_amdgcn_mfma_f32_16x16x32_bf16(Bt_[n][k], At[m][k], acc[ai][bj][m][n], 0, 0, 0); } \
        __builtin_amdgcn_s_setprio(0); } while (0)
#define GM_WAIT_V(n) asm volatile("s_waitcnt vmcnt(" #n ")" ::: "memory")
#define GM_WAIT_L(n) asm volatile("s_waitcnt lgkmcnt(" #n ")" ::: "memory")
#define GM_BAR __builtin_amdgcn_s_barrier()
#define GM_SCHED __builtin_amdgcn_sched_barrier(0)
#define GM_OFFS(dst, uix) do { _Pragma("unroll") for (int h = 0; h < 2; ++h) _Pragma("unroll") for (int i = 0; i < 2; ++i) dst[h][i] = (unsigned)(idx[(uix) * 256 + h * 128 + Rr[i]] * lda + Cc[i]) * 2u; } while (0)
    f32x4 acc[2][2][4][2];
#pragma unroll
    for (int a = 0; a < 2; ++a)
#pragma unroll
        for (int b = 0; b < 2; ++b)
#pragma unroll
            for (int m = 0; m < 4; ++m)
#pragma unroll
                for (int n = 0; n < 2; ++n) acc[a][b][m][n] = (f32x4){0.f, 0.f, 0.f, 0.f};
    bf16x8 At[4][2], B0[2][2], B1[2][2]; v8i At8[4], B08[2], B18[2];
    const int scl_w = 0x7A7A7A7A, scl_a = scl_a_;
    unsigned offc[2][2] = {{0u, 0u}, {0u, 0u}}, offn[2][2] = {{0u, 0u}, {0u, 0u}};
    if constexpr (GATHER) GM_OFFS(offc, 0);
    const char* Ab = (const char*)A; const char* Bb = (const char*)Bt;
    const char* cA = GATHER ? Ab : Ab + (size_t)cur.g * a_gs * 2 + (size_t)cur.pm * tstepA;
    const char* cB = Bb + (size_t)cur.g * b_gs * 2 + (size_t)cur.pn * tstepB;
    GM_STAGE_B(GM_SB(0, 0), cB); GM_STAGE_B(GM_SB(0, 1), cB + hstepB); GM_STAGE_A(GM_SA(0, 0), cA, 0, offc); GM_STAGE_A(GM_SA(0, 1), cA, 1, offc);
    if (wr == 1) GM_BAR;
    GM_WAIT_V(2); GM_BAR;
    GM_STAGE_B(GM_SB(1, 0), cB + kstep); GM_STAGE_A(GM_SA(1, 0), cA + kstep, 0, offc); GM_STAGE_B(GM_SB(1, 1), cB + hstepB + kstep);
    GM_WAIT_V(6); GM_BAR;
    for (;;) {
        const bool has_next = S.next(ui + 1, nxt);
        const char* nA = GATHER ? Ab : (has_next ? Ab + (size_t)nxt.g * a_gs * 2 + (size_t)nxt.pm * tstepA : cA);
        const char* nB = has_next ? Bb + (size_t)nxt.g * b_gs * 2 + (size_t)nxt.pn * tstepB : cB;
        if constexpr (GATHER) { if (has_next) GM_OFFS(offn, ui + 1); else {
#pragma unroll
            for (int h = 0; h < 2; ++h)
#pragma unroll
                for (int i = 0; i < 2; ++i) offn[h][i] = offc[h][i]; } }
#pragma nounroll
        for (int t = 0; t < nt; t += 2) {
            const bool last = (t == nt - 2);
            const char* a1 = cA + (size_t)(t + 1) * kstep;
            const char* a2 = last ? nA : cA + (size_t)(t + 2) * kstep; const char* b2 = last ? nB : cB + (size_t)(t + 2) * kstep;
            const char* a3 = a2 + kstep; const char* b3 = b2 + kstep;
            unsigned o2[2][2];
#pragma unroll
            for (int h = 0; h < 2; ++h)
#pragma unroll
                for (int i = 0; i < 2; ++i) o2[h][i] = last ? offn[h][i] : offc[h][i];
            GM_LDB(B0, 0, 0); GM_LDB(B1, 0, 1); GM_SCHED; GM_LDA(At, 0, 0); GM_STAGE_A(GM_SA(1, 1), a1, 1, offc);
            GM_WAIT_V(8); GM_WAIT_L(0); GM_BAR; GM_MMA(0, 0, At, B0); GM_MMA(0, 1, At, B1); GM_BAR; GM_SCHED;
            GM_LDA(At, 0, 1); GM_STAGE_B(GM_SB(0, 0), b2); GM_STAGE_B(GM_SB(0, 1), b2 + hstepB); GM_STAGE_A(GM_SA(0, 0), a2, 0, o2);
            GM_WAIT_V(8); GM_WAIT_L(0); GM_BAR; GM_MMA(1, 0, At, B0); GM_MMA(1, 1, At, B1); GM_BAR; GM_SCHED;
            GM_LDB(B0, 1, 0); GM_LDB(B1, 1, 1); GM_SCHED; GM_LDA(At, 1, 0); GM_STAGE_A(GM_SA(0, 1), a2, 1, o2);
            GM_WAIT_V(8); GM_WAIT_L(0); GM_BAR; GM_MMA(0, 0, At, B0); GM_MMA(0, 1, At, B1); GM_BAR; GM_SCHED;
            GM_LDA(At, 1, 1); GM_STAGE_B(GM_SB(1, 0), b3); GM_STAGE_B(GM_SB(1, 1), b3 + hstepB); GM_STAGE_A(GM_SA(1, 0), a3, 0, o2);
            GM_WAIT_V(8); GM_WAIT_L(0); GM_BAR; GM_MMA(1, 0, At, B0); GM_MMA(1, 1, At, B1); GM_BAR; GM_SCHED;
        }
        if (wr == 0) GM_BAR;
        if constexpr (F8) asm volatile("s_nop 15\n\ts_nop 15" ::: "memory");
        E(acc, cur, wr, wc, fr, fq);
        if (!has_next) break;
#pragma unroll
        for (int a = 0; a < 2; ++a)
#pragma unroll
            for (int b = 0; b < 2; ++b)
#pragma unroll
                for (int m = 0; m < 4; ++m)
#pragma unroll
                    for (int n = 0; n < 2; ++n) acc[a][b][m][n] = (f32x4){0.f, 0.f, 0.f, 0.f};
        cur = nxt; cA = nA; cB = nB; ++ui;
#pragma unroll
        for (int h = 0; h < 2; ++h)
#pragma unroll
            for (int i = 0; i < 2; ++i) offc[h][i] = offn[h][i];
        if (wr == 1) GM_BAR;
    }
    GM_WAIT_V(0);
    GM_BAR;
#undef GM_SA
#undef GM_SB
#undef GM_LD2
#undef GM_STAGE_B
#undef GM_STAGE_A
#undef GM_LDA
#undef GM_LDB
#undef GM_MMA
#undef GM_WAIT_V
#undef GM_WAIT_L
#undef GM_BAR
#undef GM_SCHED
#undef GM_OFFS
}
}

namespace at {
constexpr int NW = 8, QBLK = 32, KVBLK = 64;
constexpr float THR = 8.f;
#define AT_KSWZ(RB, row, colB) ((row) * (RB) + ((colB) ^ (((row) & 7) << 4)))
#define AT_SBAR() __builtin_amdgcn_sched_barrier(0)
__device__ __forceinline__ int crow(int r, int hi) { return (r & 3) + 8 * (r >> 2) + 4 * hi; }
__device__ __forceinline__ unsigned cvtpk(float lo, float hi) { unsigned r; asm volatile("v_cvt_pk_bf16_f32 %0, %1, %2" : "=v"(r) : "v"(lo), "v"(hi)); return r; }

template <int QM> struct Cst { static constexpr float SCALE = QM == 0 ? 0.088388347648318440f : 0.072168783648703220f; static constexpr float C = SCALE * 1.4426950408889634f; };

template <int QM, int THRI = 8>
__device__ __forceinline__ void partialSM(f32x16& p0, f32x16& p1, float& m_reg, float& mn, float& alpha) {
  constexpr float C = Cst<QM>::C, SC = Cst<QM>::SCALE, THR = (float)THRI;
  float pmax = p0[0];
#pragma unroll
  for (int r = 1; r < 16; ++r) pmax = fmaxf(pmax, p0[r]);
#pragma unroll
  for (int r = 0; r < 16; ++r) pmax = fmaxf(pmax, p1[r]);
  { auto rr = __builtin_amdgcn_permlane32_swap(__float_as_uint(pmax), __float_as_uint(pmax), false, false);
    pmax = fmaxf(__uint_as_float(rr[0]), __uint_as_float(rr[1])); }
  if (__builtin_expect(__all(pmax - m_reg <= THR / SC), 1)) { mn = m_reg; alpha = 1.f; }
  else { mn = fmaxf(m_reg, pmax); alpha = __builtin_amdgcn_exp2f((m_reg - mn) * C); m_reg = mn; }
  float mnC = -mn * C;
#pragma unroll
  for (int r = 0; r < 16; ++r) p0[r] = fmaf(p0[r], C, mnC);
#pragma unroll
  for (int r = 0; r < 16; ++r) p1[r] = fmaf(p1[r], C, mnC);
#pragma unroll
  for (int r = 0; r < 16; ++r) p0[r] = __builtin_amdgcn_exp2f(p0[r]);
}
__device__ __forceinline__ void finishSM(f32x16& p0, f32x16& p1, float alpha, float& l_reg, bf16x8& pa0, bf16x8& pa1, bf16x8& pa2, bf16x8& pa3) {
#pragma unroll
  for (int r = 0; r < 16; ++r) p1[r] = __builtin_amdgcn_exp2f(p1[r]);
  float ps = 0;
#pragma unroll
  for (int r = 0; r < 16; ++r) ps += p0[r];
#pragma unroll
  for (int r = 0; r < 16; ++r) ps += p1[r];
  { auto rr = __builtin_amdgcn_permlane32_swap(__float_as_uint(ps), __float_as_uint(ps), false, false);
    ps = __uint_as_float(rr[0]) + __uint_as_float(rr[1]); }
  l_reg = l_reg * alpha + ps;
#define AT_PK4(P, BASE, OUT) do { unsigned a0 = cvtpk(P[BASE + 0], P[BASE + 1]), a1 = cvtpk(P[BASE + 2], P[BASE + 3]);   \
    unsigned b0 = cvtpk(P[BASE + 4], P[BASE + 5]), b1 = cvtpk(P[BASE + 6], P[BASE + 7]);                              \
    auto r0 = __builtin_amdgcn_permlane32_swap(a0, b0, false, false); auto r1 = __builtin_amdgcn_permlane32_swap(a1, b1, false, false); \
    u32x4 w = {r0[0], r1[0], r0[1], r1[1]}; OUT = *reinterpret_cast<bf16x8*>(&w); } while (0)
  AT_PK4(p0, 0, pa0); AT_PK4(p0, 8, pa1); AT_PK4(p1, 0, pa2); AT_PK4(p1, 8, pa3);
#undef AT_PK4
}
template <int DQK>
__device__ __forceinline__ void qkt(f32x16& p0, f32x16& p1, const LAS char* kb, const bf16x8* qr) {
  constexpr int RBP = DQK * 2 + 16;
  p0 = f32x16{}; p1 = f32x16{};
#pragma unroll
  for (int d0 = 0; d0 < DQK / 16; ++d0) {
    bf16x8 b0 = *reinterpret_cast<const LAS bf16x8*>(kb + d0 * 32);
    bf16x8 b1 = *reinterpret_cast<const LAS bf16x8*>(kb + 32 * RBP + d0 * 32);
    p0 = __builtin_amdgcn_mfma_f32_32x32x16_bf16(b0, qr[d0], p0, 0, 0, 0);
    p1 = __builtin_amdgcn_mfma_f32_32x32x16_bf16(b1, qr[d0], p1, 0, 0, 0); }
}
__device__ __forceinline__ void finishSM8(f32x16& p0, f32x16& p1, float alpha, float& l_reg, v8i& p8) {
#pragma unroll
  for (int r = 0; r < 16; ++r) p1[r] = __builtin_amdgcn_exp2f(p1[r]);
  float ps = 0;
#pragma unroll
  for (int r = 0; r < 16; ++r) ps += p0[r];
#pragma unroll
  for (int r = 0; r < 16; ++r) ps += p1[r];
  { auto rr = __builtin_amdgcn_permlane32_swap(__float_as_uint(ps), __float_as_uint(ps), false, false);
    ps = __uint_as_float(rr[0]) + __uint_as_float(rr[1]); }
  l_reg = l_reg * alpha + ps;
#pragma unroll
  for (int q = 0; q < 4; ++q) { const unsigned g0 = cvt4_fp8(p0[4 * q], p0[4 * q + 1], p0[4 * q + 2], p0[4 * q + 3]), g1 = cvt4_fp8(p1[4 * q], p1[4 * q + 1], p1[4 * q + 2], p1[4 * q + 3]);
    auto rr = __builtin_amdgcn_permlane32_swap(g0, g1, false, false); p8[q] = (int)rr[0]; p8[4 + q] = (int)rr[1]; }
}
__device__ __forceinline__ void pv8(f32x16* o, const LAS char* vb, const v8i& p8, int scl) {
  constexpr int RPV = KVBLK + 16;
  v8i v[4];
#pragma unroll
  for (int d0 = 0; d0 < 4; ++d0) v[d0] = __builtin_shufflevector(*(const LAS v4i*)(vb + d0 * 32 * RPV), *(const LAS v4i*)(vb + d0 * 32 * RPV + 16), 0, 1, 2, 3, 4, 5, 6, 7);
  asm volatile("v_mfma_scale_f32_32x32x64_f8f6f4 %0, %1, %2, %0, %3, %3 op_sel_hi:[0,0,0]" : "+v"(o[0]) : "v"(p8), "v"(v[0]), "v"(scl));
  asm volatile("v_mfma_scale_f32_32x32x64_f8f6f4 %0, %1, %2, %0, %3, %3 op_sel_hi:[0,0,0]" : "+v"(o[1]) : "v"(p8), "v"(v[1]), "v"(scl));
  asm volatile("v_mfma_scale_f32_32x32x64_f8f6f4 %0, %1, %2, %0, %3, %3 op_sel_hi:[0,0,0]" : "+v"(o[2]) : "v"(p8), "v"(v[2]), "v"(scl));
  asm volatile("v_mfma_scale_f32_32x32x64_f8f6f4 %0, %1, %2, %0, %3, %3 op_sel_hi:[0,0,0]\n\ts_nop 15\n\ts_nop 15" : "+v"(o[3]) : "v"(p8), "v"(v[3]), "v"(scl));
}
template <int QM, int THRI>
__device__ __forceinline__ void pv8_psm(f32x16* o, const LAS char* vb, const v8i& p8, int scl, f32x16& p0, f32x16& p1, float& m_reg, float& mn, float& alpha) {
  constexpr int RPV = KVBLK + 16; constexpr float C = Cst<QM>::C, SC = Cst<QM>::SCALE, THR = (float)THRI;
  v8i v[4];
#pragma unroll
  for (int d0 = 0; d0 < 4; ++d0) v[d0] = __builtin_shufflevector(*(const LAS v4i*)(vb + d0 * 32 * RPV), *(const LAS v4i*)(vb + d0 * 32 * RPV + 16), 0, 1, 2, 3, 4, 5, 6, 7);
  asm volatile("v_mfma_scale_f32_32x32x64_f8f6f4 %0, %1, %2, %0, %3, %3 op_sel_hi:[0,0,0]" : "+v"(o[0]) : "v"(p8), "v"(v[0]), "v"(scl));
  float pmax = p0[0];
#pragma unroll
  for (int r = 1; r < 16; ++r) pmax = fmaxf(pmax, p0[r]);
  AT_SBAR();
  asm volatile("v_mfma_scale_f32_32x32x64_f8f6f4 %0, %1, %2, %0, %3, %3 op_sel_hi:[0,0,0]" : "+v"(o[1]) : "v"(p8), "v"(v[1]), "v"(scl));
#pragma unroll
  for (int r = 0; r < 16; ++r) pmax = fmaxf(pmax, p1[r]);
  { auto rr = __builtin_amdgcn_permlane32_swap(__float_as_uint(pmax), __float_as_uint(pmax), false, false);
    pmax = fmaxf(__uint_as_float(rr[0]), __uint_as_float(rr[1])); }
  if (__builtin_expect(__all(pmax - m_reg <= THR / SC), 1)) { mn = m_reg; alpha = 1.f; }
  else { mn = fmaxf(m_reg, pmax); alpha = __builtin_amdgcn_exp2f((m_reg - mn) * C); m_reg = mn; }
  const float mnC = -mn * C;
  AT_SBAR();
  asm volatile("v_mfma_scale_f32_32x32x64_f8f6f4 %0, %1, %2, %0, %3, %3 op_sel_hi:[0,0,0]" : "+v"(o[2]) : "v"(p8), "v"(v[2]), "v"(scl));
#pragma unroll
  for (int r = 0; r < 16; ++r) p0[r] = fmaf(p0[r], C, mnC);
#pragma unroll
  for (int r = 0; r < 16; ++r) p1[r] = fmaf(p1[r], C, mnC);
  AT_SBAR();
  asm volatile("v_mfma_scale_f32_32x32x64_f8f6f4 %0, %1, %2, %0, %3, %3 op_sel_hi:[0,0,0]" : "+v"(o[3]) : "v"(p8), "v"(v[3]), "v"(scl));
#pragma unroll
  for (int r = 0; r < 16; ++r) p0[r] = __builtin_amdgcn_exp2f(p0[r]);
  AT_SBAR();
}
template <int DQK>
__device__ __forceinline__ void qkt8(f32x16& p0, f32x16& p1, const LAS char* kb, const LAS char* kbp, const v8i* q8, int scl) {
  constexpr int RP8 = DQK + 16, NS = DQK / 64;
  v8i a0[NS], a1[NS];
#pragma unroll
  for (int s = 0; s < NS; ++s) {
    const LAS char* c0 = (DQK == 192 && s == 2) ? kbp : kb + 64 * s; const int d2 = (DQK == 192 && s == 2) ? 32 : 16;
    a0[s] = __builtin_shufflevector(*(const LAS v4i*)(c0), *(const LAS v4i*)(c0 + d2), 0, 1, 2, 3, 4, 5, 6, 7);
    a1[s] = __builtin_shufflevector(*(const LAS v4i*)(c0 + 32 * RP8), *(const LAS v4i*)(c0 + 32 * RP8 + d2), 0, 1, 2, 3, 4, 5, 6, 7); }
  asm volatile("v_mfma_scale_f32_32x32x64_f8f6f4 %0, %1, %2, 0, %3, %3 op_sel_hi:[0,0,0]" : "=&v"(p0) : "v"(a0[0]), "v"(q8[0]), "v"(scl));
  asm volatile("v_mfma_scale_f32_32x32x64_f8f6f4 %0, %1, %2, 0, %3, %3 op_sel_hi:[0,0,0]" : "=&v"(p1) : "v"(a1[0]), "v"(q8[0]), "v"(scl));
  if constexpr (NS == 3) {
    asm volatile("v_mfma_scale_f32_32x32x64_f8f6f4 %0, %1, %2, %0, %3, %3 op_sel_hi:[0,0,0]" : "+v"(p0) : "v"(a0[1]), "v"(q8[1]), "v"(scl));
    asm volatile("v_mfma_scale_f32_32x32x64_f8f6f4 %0, %1, %2, %0, %3, %3 op_sel_hi:[0,0,0]" : "+v"(p1) : "v"(a1[1]), "v"(q8[1]), "v"(scl)); }
  asm volatile("v_mfma_scale_f32_32x32x64_f8f6f4 %0, %2, %4, %0, %5, %5 op_sel_hi:[0,0,0]\n\tv_mfma_scale_f32_32x32x64_f8f6f4 %1, %3, %4, %1, %5, %5 op_sel_hi:[0,0,0]\n\ts_nop 15\n\ts_nop 15"
               : "+v"(p0), "+v"(p1) : "v"(a0[NS - 1]), "v"(a1[NS - 1]), "v"(q8[NS - 1]), "v"(scl));
}
__device__ __forceinline__ v8i pack32_fp8(const float (&x)[32]) { v8i r;
#pragma unroll
  for (int q = 0; q < 8; ++q) r[q] = (int)cvt4_fp8(x[4 * q], x[4 * q + 1], x[4 * q + 2], x[4 * q + 3]);
  return r; }
__device__ __forceinline__ void ld16_bf16(const bf16_t* p, float* x) {
  const u32x4 r0 = *reinterpret_cast<const u32x4*>(p), r1 = *reinterpret_cast<const u32x4*>(p + 8);
#pragma unroll
  for (int j = 0; j < 4; ++j) { x[2 * j] = bf_lo(r0[j]); x[2 * j + 1] = bf_hi(r0[j]); x[8 + 2 * j] = bf_lo(r1[j]); x[8 + 2 * j + 1] = bf_hi(r1[j]); } }
__device__ __forceinline__ int v_st(int k, int c) { const int kk = (k & ~0xC) | ((k & 4) << 1) | ((k & 8) >> 1); return ((kk >> 3) * 4 + (c >> 5)) * 512 + ((kk & 7) * 32 + (c & 31)) * 2; }
__device__ __forceinline__ int v_rd_base(int lane) { return ((lane & 3) << 3) | (((lane >> 2) & 3) << 6) | (((lane >> 4) & 1) << 5) | (((lane >> 5) & 1) << 8); }
constexpr int v_rd_off(int d0, int ks, int half) { return d0 * 512 + ks * 4096 + half * 2048; }
template <int OFF> __device__ __forceinline__ s16x4 tr_read(int vb) {
  s16x4 r; asm volatile("ds_read_b64_tr_b16 %0, %1 offset:%2" : "=&v"(r) : "v"(vb), "i"(OFF) : "memory"); return r;
}
template <int D0> __device__ __forceinline__ void pv_one(f32x16& od, int vb, bf16x8 pa0, bf16x8 pa1, bf16x8 pa2, bf16x8 pa3) {
  const s16x4 l0 = tr_read<v_rd_off(D0, 0, 0)>(vb), h0 = tr_read<v_rd_off(D0, 0, 1)>(vb), l1 = tr_read<v_rd_off(D0, 1, 0)>(vb), h1 = tr_read<v_rd_off(D0, 1, 1)>(vb);
  const s16x4 l2 = tr_read<v_rd_off(D0, 2, 0)>(vb), h2 = tr_read<v_rd_off(D0, 2, 1)>(vb), l3 = tr_read<v_rd_off(D0, 3, 0)>(vb), h3 = tr_read<v_rd_off(D0, 3, 1)>(vb);
  asm volatile("s_waitcnt lgkmcnt(0)" ::: "memory"); AT_SBAR();
#define AT_PK(L, H) (bf16x8){L[0], L[1], L[2], L[3], H[0], H[1], H[2], H[3]}
  od = __builtin_amdgcn_mfma_f32_32x32x16_bf16(pa0, AT_PK(l0, h0), od, 0, 0, 0);
  od = __builtin_amdgcn_mfma_f32_32x32x16_bf16(pa1, AT_PK(l1, h1), od, 0, 0, 0);
  od = __builtin_amdgcn_mfma_f32_32x32x16_bf16(pa2, AT_PK(l2, h2), od, 0, 0, 0);
  od = __builtin_amdgcn_mfma_f32_32x32x16_bf16(pa3, AT_PK(l3, h3), od, 0, 0, 0);
#undef AT_PK
}
__device__ __forceinline__ void pv_d0(f32x16* o, int vb, bf16x8 pa0, bf16x8 pa1, bf16x8 pa2, bf16x8 pa3) {
  pv_one<0>(o[0], vb, pa0, pa1, pa2, pa3); pv_one<1>(o[1], vb, pa0, pa1, pa2, pa3); pv_one<2>(o[2], vb, pa0, pa1, pa2, pa3); pv_one<3>(o[3], vb, pa0, pa1, pa2, pa3);
}

template <int DQK, int SDEPTH, int QM, int ldq, int ldk, int ldv, int ldo, bool O8 = false>
__device__ __forceinline__ void attn_body(const bf16_t* __restrict__ Qb, const bf16_t* __restrict__ Kn, const bf16_t* __restrict__ Kp,
                                          const bf16_t* __restrict__ Vh, bf16_t* __restrict__ Ob, int seq, LAS char* lds,
                                          bool rope, int pos0, const float* __restrict__ qg, const float* __restrict__ tcos, const float* __restrict__ tsin, int wv) {
  constexpr int RBP = DQK * 2 + 16, SHM_V = KVBLK * 128 * 2, SHM_K = KVBLK * RBP, ND = DQK / 16;
  const int lane = lane_id(), wid = wv, tid = wv * 64 + lane;
  const int r32 = lane & 31, hi = lane >> 5;
  LAS char* V_lds = lds; LAS char* K_lds = lds + 2 * SHM_V;
  LAS float* ws = (LAS float*)(lds + 2 * SHM_V + 2 * SHM_K) + wid * 64; LAS float* li_l = ws; LAS float* al_l = ws + 32;
  float m_reg = -1e30f, l_reg = 0; f32x16 o[4] = {}; bf16x8 qr[ND];
  {
    const bf16_t* Qw = Qb + (size_t)(wid * QBLK + r32) * ldq + hi * 8;
    const int spos = pos0 + wid * QBLK + r32;
    if constexpr (QM == 0) {
      float xf[8][8]; float ss = 0.f;
#pragma unroll
      for (int d0 = 0; d0 < 8; ++d0) { const u32x4 raw = *reinterpret_cast<const u32x4*>(Qw + d0 * 16);
#pragma unroll
        for (int j = 0; j < 4; ++j) { xf[d0][2 * j] = bf_lo(raw[j]); xf[d0][2 * j + 1] = bf_hi(raw[j]); }
#pragma unroll
        for (int j = 0; j < 8; ++j) ss += xf[d0][j] * xf[d0][j]; }
      ss += __shfl_xor(ss, 32);
      const float rstd = rsqrtf(ss * (1.f / 128.f) + EPS);
#pragma unroll
      for (int d0 = 0; d0 < 8; ++d0) { const f32x4 g0 = *reinterpret_cast<const f32x4*>(qg + d0 * 16 + hi * 8), g1 = *reinterpret_cast<const f32x4*>(qg + d0 * 16 + hi * 8 + 4);
#pragma unroll
        for (int j = 0; j < 4; ++j) { xf[d0][j] *= rstd * g0[j]; xf[d0][4 + j] *= rstd * g1[j]; } }
      if (rope) {
#pragma unroll
        for (int d0 = 0; d0 < 4; ++d0) { const float* tc = tcos + (size_t)spos * 64 + d0 * 16 + hi * 8; const float* tsn = tsin + (size_t)spos * 64 + d0 * 16 + hi * 8;
          const f32x4 c0 = *reinterpret_cast<const f32x4*>(tc), c1 = *reinterpret_cast<const f32x4*>(tc + 4), s0 = *reinterpret_cast<const f32x4*>(tsn), s1 = *reinterpret_cast<const f32x4*>(tsn + 4);
#pragma unroll
          for (int j = 0; j < 8; ++j) { const float c = j < 4 ? c0[j & 3] : c1[j & 3], s = j < 4 ? s0[j & 3] : s1[j & 3];
            const float x1 = xf[d0][j], x2 = xf[d0 + 4][j]; xf[d0][j] = x1 * c - x2 * s; xf[d0 + 4][j] = x1 * s + x2 * c; } }
      }
#pragma unroll
      for (int d0 = 0; d0 < 8; ++d0) { u32x4 w = {cvt_pk_bf16(xf[d0][0], xf[d0][1]), cvt_pk_bf16(xf[d0][2], xf[d0][3]), cvt_pk_bf16(xf[d0][4], xf[d0][5]), cvt_pk_bf16(xf[d0][6], xf[d0][7])};
        qr[d0] = *reinterpret_cast<bf16x8*>(&w); }
    } else {
#pragma unroll
      for (int d0 = 0; d0 < 8; ++d0) qr[d0] = *reinterpret_cast<const bf16x8*>(Qw + d0 * 16);
      float xf[4][8];
#pragma unroll
      for (int d0 = 0; d0 < 4; ++d0) { const u32x4 raw = *reinterpret_cast<const u32x4*>(Qw + 128 + d0 * 16);
#pragma unroll
        for (int j = 0; j < 4; ++j) { xf[d0][2 * j] = bf_lo(raw[j]); xf[d0][2 * j + 1] = bf_hi(raw[j]); } }
      if (rope) {
#pragma unroll
        for (int d0 = 0; d0 < 2; ++d0) { const float* tc = tcos + (size_t)spos * 32 + d0 * 16 + hi * 8; const float* tsn = tsin + (size_t)spos * 32 + d0 * 16 + hi * 8;
          const f32x4 c0 = *reinterpret_cast<const f32x4*>(tc), c1 = *reinterpret_cast<const f32x4*>(tc + 4), s0 = *reinterpret_cast<const f32x4*>(tsn), s1 = *reinterpret_cast<const f32x4*>(tsn + 4);
#pragma unroll
          for (int j = 0; j < 8; ++j) { const float c = j < 4 ? c0[j & 3] : c1[j & 3], s = j < 4 ? s0[j & 3] : s1[j & 3];
            const float x1 = xf[d0][j], x2 = xf[d0 + 2][j]; xf[d0][j] = x1 * c - x2 * s; xf[d0 + 2][j] = x1 * s + x2 * c; } }
      }
#pragma unroll
      for (int d0 = 0; d0 < 4; ++d0) { u32x4 w = {cvt_pk_bf16(xf[d0][0], xf[d0][1]), cvt_pk_bf16(xf[d0][2], xf[d0][3]), cvt_pk_bf16(xf[d0][4], xf[d0][5]), cvt_pk_bf16(xf[d0][6], xf[d0][7])};
        qr[8 + d0] = *reinterpret_cast<bf16x8*>(&w); }
    }
  }
  const int sr = tid >> 4, sc = (tid & 15) * 8, vst0 = v_st(sr, sc), vst1 = v_st(32 + sr, sc);
  const int pr = tid >> 3, pc = (tid & 7) * 8;
  const int vb0 = (int)(uintptr_t)V_lds + v_rd_base(lane);
  const LAS char* kb0 = K_lds + r32 * RBP + hi * 16;
  const int kst = sr * RBP + sc * 2, kpst = pr * RBP + (128 + pc) * 2;
  const unsigned voK = (unsigned)(sr * ldk + sc) * 2u, voV = (unsigned)(sr * ldv + sc) * 2u, voP = (unsigned)(pr * 64 + pc) * 2u;
  const char* Kc = (const char*)Kn; const char* Vc = (const char*)Vh; const char* Pc = (const char*)Kp;
  struct { bf16x8 vs0, vs1, ks0, ks1, kp; } sr_[SDEPTH];
#define AT_SLOAD(i, k0) do { const char* vb_ = Vc + (size_t)(k0) * (ldv * 2); const char* kb_ = Kc + (size_t)(k0) * (ldk * 2); \
    sr_[i].vs0 = *reinterpret_cast<const bf16x8*>(vb_ + voV); sr_[i].vs1 = *reinterpret_cast<const bf16x8*>(vb_ + 32 * ldv * 2 + voV); \
    sr_[i].ks0 = *reinterpret_cast<const bf16x8*>(kb_ + voK); sr_[i].ks1 = *reinterpret_cast<const bf16x8*>(kb_ + 32 * ldk * 2 + voK); \
    if constexpr (DQK == 192) sr_[i].kp = *reinterpret_cast<const bf16x8*>(Pc + (size_t)(k0) * 128 + voP); } while (0)
#define AT_SWRITE(b, i) do { *(LAS bf16x8*)(V_lds + (b) * SHM_V + vst0) = sr_[i].vs0; *(LAS bf16x8*)(V_lds + (b) * SHM_V + vst1) = sr_[i].vs1; \
    *(LAS bf16x8*)(K_lds + (b) * SHM_K + kst) = sr_[i].ks0; *(LAS bf16x8*)(K_lds + (b) * SHM_K + 32 * RBP + kst) = sr_[i].ks1; \
    if constexpr (DQK == 192) *(LAS bf16x8*)(K_lds + (b) * SHM_K + kpst) = sr_[i].kp; } while (0)
#define AT_SWAIT() do { if constexpr (SDEPTH == 2) { if constexpr (DQK == 192) asm volatile("s_waitcnt vmcnt(5)" ::: "memory"); else asm volatile("s_waitcnt vmcnt(4)" ::: "memory"); } \
    else asm volatile("s_waitcnt vmcnt(0)" ::: "memory"); } while (0)
#define AT_RESC(a) do { if (__any((a) < 1.f)) { if (hi == 0) al_l[r32] = (a); asm volatile("s_waitcnt lgkmcnt(0)" ::: "memory"); \
    _Pragma("unroll") for (int d = 0; d < 4; ++d) _Pragma("unroll") for (int r = 0; r < 16; ++r) o[d][r] *= al_l[crow(r, hi)]; } } while (0)
  f32x16 pA0, pA1, pB0, pB1; float mnA, mnB, alA, alB; bf16x8 pa0, pa1, pa2, pa3; const int NT = seq / KVBLK;
  constexpr int SE = 0, SO = SDEPTH - 1;
  AT_SLOAD(SE, 0); asm volatile("s_waitcnt vmcnt(0)" ::: "memory"); AT_SWRITE(0, SE); __syncthreads();
  qkt<DQK>(pA0, pA1, kb0, qr); partialSM<QM>(pA0, pA1, m_reg, mnA, alA);
  AT_SLOAD(SO, KVBLK); if constexpr (SDEPTH == 2) { if (2 < NT) AT_SLOAD(SE, 2 * KVBLK); }
  AT_SWAIT(); AT_SWRITE(1, SO); __syncthreads();
  for (int j = 1; j + 1 < NT; j += 2) {
    AT_SBAR(); qkt<DQK>(pB0, pB1, kb0 + SHM_K, qr);
    finishSM(pA0, pA1, alA, l_reg, pa0, pa1, pa2, pa3); AT_SBAR();
    AT_SLOAD(SO, (j + SDEPTH) * KVBLK); AT_SBAR();
    pv_d0(o, vb0, pa0, pa1, pa2, pa3); partialSM<QM>(pB0, pB1, m_reg, mnB, alB);
    __syncthreads(); AT_SWAIT(); AT_SWRITE(0, SE);
    AT_RESC(alB); __syncthreads();
    AT_SBAR(); qkt<DQK>(pA0, pA1, kb0, qr);
    finishSM(pB0, pB1, alB, l_reg, pa0, pa1, pa2, pa3); AT_SBAR();
    if (SDEPTH == 1 || j + 3 < NT) AT_SLOAD(SE, (j + 1 + SDEPTH) * KVBLK); AT_SBAR();
    pv_d0(o, vb0 + SHM_V, pa0, pa1, pa2, pa3); partialSM<QM>(pA0, pA1, m_reg, mnA, alA);
    __syncthreads(); AT_SWAIT(); AT_SWRITE(1, SO);
    AT_RESC(alA); __syncthreads();
  }
  AT_SBAR(); qkt<DQK>(pB0, pB1, kb0 + SHM_K, qr);
  finishSM(pA0, pA1, alA, l_reg, pa0, pa1, pa2, pa3); AT_SBAR();
  pv_d0(o, vb0, pa0, pa1, pa2, pa3); partialSM<QM>(pB0, pB1, m_reg, mnB, alB);
  __syncthreads(); AT_RESC(alB);
  finishSM(pB0, pB1, alB, l_reg, pa0, pa1, pa2, pa3); AT_SBAR();
  pv_d0(o, vb0 + SHM_V, pa0, pa1, pa2, pa3);
  if (hi == 0) li_l[r32] = l_reg; asm volatile("s_waitcnt lgkmcnt(0)" ::: "memory");
  float rli[16];
#pragma unroll
  for (int r = 0; r < 16; ++r) rli[r] = __builtin_amdgcn_rcpf(li_l[crow(r, hi)]);
  if constexpr (O8) {
    unsigned char* Ow = (unsigned char*)Ob + (size_t)(wid * QBLK) * ldo;
#pragma unroll
    for (int r = 0; r < 16; ++r) { const int orow = crow(r, hi);
#pragma unroll
      for (int d0 = 0; d0 < 4; ++d0) { const float v = o[d0][r] * rli[r] * 16.f; Ow[(size_t)orow * ldo + d0 * 32 + r32] = (unsigned char)(cvt4_fp8(v, 0.f, 0.f, 0.f) & 0xffu); } }
  } else {
  bf16_t* Ow = Ob + (size_t)(wid * QBLK) * ldo;
#pragma unroll
  for (int r = 0; r < 16; ++r) { const int orow = crow(r, hi);
#pragma unroll
    for (int d0 = 0; d0 < 4; ++d0) Ow[(size_t)orow * ldo + d0 * 32 + r32] = (bf16_t)(cvt_pk_bf16(o[d0][r] * rli[r], 0.f) & 0xffffu); }
  }
  __syncthreads();
#undef AT_SLOAD
#undef AT_SWRITE
#undef AT_SWAIT
#undef AT_RESC
}

template <int DQK, int QM, int ldq, int ldk8, int ldo, bool O8, int SDEPTH>
__device__ __forceinline__ void attn_body8(const bf16_t* __restrict__ Qb, const unsigned char* __restrict__ Kn8, const unsigned char* __restrict__ Kp8,
                                           const unsigned char* __restrict__ Vt8, bf16_t* __restrict__ Ob, int seq, LAS char* lds,
                                           bool rope, int pos0, const float* __restrict__ qg, const float* __restrict__ tcos, const float* __restrict__ tsin, int wv) {
  constexpr int RP8 = DQK + 16, RPV = KVBLK + 16, SHM_V = 128 * RPV, SHM_K = KVBLK * RP8, NS = DQK / 64;
  const int lane = lane_id(), wid = wv, tid = wv * 64 + lane;
  const int r32 = lane & 31, hi = lane >> 5;
  LAS char* V_lds = lds; LAS char* K_lds = lds + 3 * SHM_V;
  LAS float* ws = (LAS float*)(lds + 3 * SHM_V + 3 * SHM_K) + wid * 64; LAS float* li_l = ws; LAS float* al_l = ws + 32;
  float m_reg = -1e30f, l_reg = 0; f32x16 o[4] = {}; v8i q8[NS];
  int scl = 0x7F7F7F7F; asm volatile("" : "+v"(scl));
  {
    const bf16_t* Qw = Qb + (size_t)(wid * QBLK + r32) * ldq;
    const int spos = pos0 + wid * QBLK + r32;
    float x0[32], x1[32];
    ld16_bf16(Qw + 32 * hi, x0); ld16_bf16(Qw + 32 * hi + 16, x0 + 16); ld16_bf16(Qw + 64 + 32 * hi, x1); ld16_bf16(Qw + 64 + 32 * hi + 16, x1 + 16);
    if constexpr (QM == 0) {
      float ss = 0.f;
#pragma unroll
      for (int t = 0; t < 32; ++t) ss += x0[t] * x0[t] + x1[t] * x1[t];
      ss += __shfl_xor(ss, 32);
      const float rstd = rsqrtf(ss * (1.f / 128.f) + EPS);
#pragma unroll
      for (int t = 0; t < 32; t += 4) { const f32x4 g0 = *reinterpret_cast<const f32x4*>(qg + 32 * hi + t), g1 = *reinterpret_cast<const f32x4*>(qg + 64 + 32 * hi + t);
#pragma unroll
        for (int j = 0; j < 4; ++j) { x0[t + j] *= rstd * g0[j]; x1[t + j] *= rstd * g1[j]; } }
      if (rope) {
#pragma unroll
        for (int t = 0; t < 32; t += 4) { const f32x4 c = *reinterpret_cast<const f32x4*>(tcos + (size_t)spos * 64 + 32 * hi + t), sn = *reinterpret_cast<const f32x4*>(tsin + (size_t)spos * 64 + 32 * hi + t);
#pragma unroll
          for (int j = 0; j < 4; ++j) { const float a = x0[t + j], b = x1[t + j]; x0[t + j] = a * c[j] - b * sn[j]; x1[t + j] = a * sn[j] + b * c[j]; } }
      }
      q8[0] = pack32_fp8(x0); q8[1] = pack32_fp8(x1);
    } else {
      q8[0] = pack32_fp8(x0); q8[1] = pack32_fp8(x1);
      float pe[32];
      ld16_bf16(Qw + 128 + 16 * hi, pe); ld16_bf16(Qw + 128 + 32 + 16 * hi, pe + 16);
      if (rope) {
#pragma unroll
        for (int t = 0; t < 16; t += 4) { const f32x4 c = *reinterpret_cast<const f32x4*>(tcos + (size_t)spos * 32 + 16 * hi + t), sn = *reinterpret_cast<const f32x4*>(tsin + (size_t)spos * 32 + 16 * hi + t);
#pragma unroll
          for (int j = 0; j < 4; ++j) { const float a = pe[t + j], b = pe[16 + t + j]; pe[t + j] = a * c[j] - b * sn[j]; pe[16 + t + j] = a * sn[j] + b * c[j]; } }
      }
      q8[NS - 1] = pack32_fp8(pe);
    }
  }
  const int vcol = tid >> 2, vpart = (tid & 3) * 16;
  const int kr = tid >> 3, kc = (tid & 7) * 16;
  const int pr = (tid & 255) >> 2, pc = (tid & 3) * 16;
  const LAS char* vb0 = V_lds + r32 * RPV + 32 * hi;
  const LAS char* kb0 = K_lds + r32 * RP8 + 32 * hi; const LAS char* kbp0 = K_lds + r32 * RP8 + 128 + 16 * hi;
  const int kst = kr * RP8 + kc, kpst = pr * RP8 + 128 + pc;
  const unsigned voV = (unsigned)(vcol * RPB + vpart), voK = (unsigned)(kr * ldk8 + kc), voP = (unsigned)(pr * 64 + pc);
  const char* Kc = (const char*)Kn8; const char* Vc = (const char*)Vt8; const char* Pc = (const char*)Kp8;
  struct { v4i vt, k8, kp8; } sr_[SDEPTH];
#define AT_SLOAD(i, k0) do { sr_[i].vt = *reinterpret_cast<const v4i*>(Vc + (size_t)(k0) + voV); \
    sr_[i].k8 = *reinterpret_cast<const v4i*>(Kc + (size_t)(k0) * ldk8 + voK); \
    if constexpr (DQK == 192) sr_[i].kp8 = *reinterpret_cast<const v4i*>(Pc + (size_t)(k0) * 64 + voP); } while (0)
#define AT_SWRITE(b, i) do { *(LAS v4i*)(V_lds + (b) * SHM_V + vcol * RPV + vpart) = sr_[i].vt; \
    *(LAS v4i*)(K_lds + (b) * SHM_K + kst) = sr_[i].k8; \
    if constexpr (DQK == 192) { if (tid < 256) *(LAS v4i*)(K_lds + (b) * SHM_K + kpst) = sr_[i].kp8; } } while (0)
#define AT_SWAIT() do { if constexpr (SDEPTH == 1) asm volatile("s_waitcnt vmcnt(0)" ::: "memory"); else if constexpr (DQK == 192) asm volatile("s_waitcnt vmcnt(3)" ::: "memory"); else asm volatile("s_waitcnt vmcnt(2)" ::: "memory"); } while (0)
#define AT_RESC(a) do { if (__any((a) < 1.f)) { if (hi == 0) al_l[r32] = (a); asm volatile("s_nop 15\n\ts_nop 15\n\ts_waitcnt lgkmcnt(0)" ::: "memory"); \
    _Pragma("unroll") for (int d = 0; d < 4; ++d) _Pragma("unroll") for (int r = 0; r < 16; ++r) o[d][r] *= al_l[crow(r, hi)]; } } while (0)
  f32x16 pA0, pA1, pB0, pB1; float mnA, mnB, alA, alB; v8i p8; const int NT = seq / KVBLK;
  static_assert(SDEPTH == 2, "the three-buffer loop stages two tiles ahead");
  constexpr int SE = 0, SO = 1;
  AT_SLOAD(SE, 0); asm volatile("s_waitcnt vmcnt(0)" ::: "memory"); AT_SWRITE(0, SE); __syncthreads();
  qkt8<DQK>(pA0, pA1, kb0, kbp0, q8, scl); partialSM<QM, 5>(pA0, pA1, m_reg, mnA, alA);
  AT_SLOAD(SO, KVBLK); AT_SLOAD(SE, (2 < NT ? 2 : NT - 1) * KVBLK);
  AT_SWAIT(); AT_SWRITE(1, SO); __syncthreads();
  int bf = 1;
  for (int j = 1; j + 1 < NT; j += 2) {
    const int b1 = bf == 2 ? 0 : bf + 1, b2 = b1 == 2 ? 0 : b1 + 1, bm1 = bf == 0 ? 2 : bf - 1;
    AT_SBAR(); qkt8<DQK>(pB0, pB1, kb0 + bf * SHM_K, kbp0 + bf * SHM_K, q8, scl);
    finishSM8(pA0, pA1, alA, l_reg, p8); AT_SBAR();
    AT_SLOAD(SO, (j + 2) * KVBLK); AT_SBAR();
    pv8_psm<QM, 5>(o, vb0 + bm1 * SHM_V, p8, scl, pB0, pB1, m_reg, mnB, alB);
    AT_SWAIT(); AT_SWRITE(b1, SE);
    AT_RESC(alB); __syncthreads();
    AT_SBAR(); qkt8<DQK>(pA0, pA1, kb0 + b1 * SHM_K, kbp0 + b1 * SHM_K, q8, scl);
    finishSM8(pB0, pB1, alB, l_reg, p8); AT_SBAR();
    AT_SLOAD(SE, (j + 3 < NT ? j + 3 : NT - 1) * KVBLK); AT_SBAR();
    pv8_psm<QM, 5>(o, vb0 + bf * SHM_V, p8, scl, pA0, pA1, m_reg, mnA, alA);
    AT_SWAIT(); AT_SWRITE(b2, SO);
    AT_RESC(alA); __syncthreads();
    bf = b2;
  }
  { const int bm1 = bf == 0 ? 2 : bf - 1;
    AT_SBAR(); qkt8<DQK>(pB0, pB1, kb0 + bf * SHM_K, kbp0 + bf * SHM_K, q8, scl);
    finishSM8(pA0, pA1, alA, l_reg, p8); AT_SBAR();
    pv8_psm<QM, 5>(o, vb0 + bm1 * SHM_V, p8, scl, pB0, pB1, m_reg, mnB, alB);
    AT_RESC(alB);
    finishSM8(pB0, pB1, alB, l_reg, p8); AT_SBAR();
    pv8(o, vb0 + bf * SHM_V, p8, scl); }
  if (hi == 0) li_l[r32] = l_reg; asm volatile("s_waitcnt lgkmcnt(0)" ::: "memory");
  float rli[16];
#pragma unroll
  for (int r = 0; r < 16; ++r) rli[r] = __builtin_amdgcn_rcpf(li_l[crow(r, hi)]);
  if constexpr (O8) {
    unsigned char* Ow = (unsigned char*)Ob + (size_t)(wid * QBLK) * ldo;
#pragma unroll
    for (int r = 0; r < 16; ++r) { const int orow = crow(r, hi);
#pragma unroll
      for (int d0 = 0; d0 < 4; ++d0) { const float v = o[d0][r] * rli[r] * 16.f; Ow[(size_t)orow * ldo + d0 * 32 + r32] = (unsigned char)(cvt4_fp8(v, 0.f, 0.f, 0.f) & 0xffu); } }
  } else {
    bf16_t* Ow = Ob + (size_t)(wid * QBLK) * ldo;
#pragma unroll
    for (int r = 0; r < 16; ++r) { const int orow = crow(r, hi);
#pragma unroll
      for (int d0 = 0; d0 < 4; ++d0) Ow[(size_t)orow * ldo + d0 * 32 + r32] = (bf16_t)(cvt_pk_bf16(o[d0][r] * rli[r], 0.f) & 0xffffu); }
  }
  __syncthreads();
#undef AT_SLOAD
#undef AT_SWRITE
#undef AT_SWAIT
#undef AT_RESC
}
}

static_assert(WS_END < (size_t)1230 * 1000 * 1000, "workspace budget");

__device__ __forceinline__ const float* mod_ptr(const Params& p, int l) { return (const float*)(p.ws + WS_MOD) + (size_t)l * 9 * 12288; }

__device__ __forceinline__ void cvt_job(const float* __restrict__ src, int K, int N, bf16_t* __restrict__ dst, int drows, int mode, const float* __restrict__ scale, int T, LAS unsigned char* lds, int t) {
    const int ntn = (N + 127) >> 7, tpe = (K >> 6) * ntn;
    const int e = T / tpe, rem = T - e * tpe, kt = rem / ntn, nt_ = rem - kt * ntn, n0 = nt_ * 128, k0 = kt * 64;
    int drow0 = n0;
    if (mode == 1) drow0 = (n0 >> 7) * 256;
    else if (mode == 2) drow0 = (n0 >> 7) * 256 + 128;
    else if (mode == 3) drow0 = n0 < 1536 ? n0 : (n0 < 2560 ? 1536 + ((n0 - 1536) >> 7) * 256 : 1536 + ((n0 - 2560) >> 7) * 256 + 128);
    const int lk = t >> 5, ln4 = (t & 31) * 4;
    const float* sp = src + (size_t)e * K * N + (size_t)(k0 + lk) * N + n0 + ln4;
    f32x4 v[4];
    const bool inb = (n0 + ln4) < N;
#pragma unroll
    for (int i = 0; i < 4; ++i) v[i] = inb ? __builtin_nontemporal_load((const f32x4*)(sp + (size_t)(16 * i) * N)) : (f32x4){0.f, 0.f, 0.f, 0.f};
    if (scale) {
#pragma unroll
        for (int i = 0; i < 4; ++i) v[i] *= scale[k0 + lk + 16 * i];
    }
#pragma unroll
    for (int i = 0; i < 4; ++i)
#pragma unroll
        for (int j = 0; j < 4; ++j) *(LAS bf16_t*)(lds + (ln4 + j) * 132 + (lk + 16 * i) * 2) = (bf16_t)(cvt_pk_bf16(v[i][j], 0.f) & 0xffffu);
    __syncthreads();
    const int n = t >> 2, kq = (t & 3) * 16;
    unsigned w[8];
#pragma unroll
    for (int q = 0; q < 8; ++q) w[q] = *(const LAS unsigned*)(lds + n * 132 + kq * 2 + q * 4);
    if (n0 + n < N) { bf16_t* d = dst + (size_t)e * drows * K + (size_t)(drow0 + n) * K + k0 + kq;
        u32x4 a = {w[0], w[1], w[2], w[3]}, b = {w[4], w[5], w[6], w[7]}; *(u32x4*)d = a; *(u32x4*)(d + 8) = b; }
    __syncthreads();
}
__device__ __forceinline__ void cvt_job_f8(const float* __restrict__ src, int K, int N, unsigned char* __restrict__ dst, int drows, int mode, const float* __restrict__ scale, int T, LAS unsigned char* lds, int t) {
    const int ntn = (N + 127) >> 7, tpe = (K >> 7) * ntn;
    const int e = T / tpe, rem = T - e * tpe, kt = rem / ntn, nt_ = rem - kt * ntn, n0 = nt_ * 128, k0 = kt * 128;
    int drow0 = n0;
    if (mode == 1) drow0 = (n0 >> 7) * 256;
    else if (mode == 2) drow0 = (n0 >> 7) * 256 + 128;
    else if (mode == 3) drow0 = n0 < 1536 ? n0 : (n0 < 2560 ? 1536 + ((n0 - 1536) >> 7) * 256 : 1536 + ((n0 - 2560) >> 7) * 256 + 128);
    const int lk = (t >> 5) * 8, ln4 = (t & 31) * 4;
    const float* sp = src + (size_t)e * K * N + (size_t)(k0 + lk) * N + n0 + ln4;
    const bool inb = (n0 + ln4) < N;
    f32x4 v[8];
#pragma unroll
    for (int i = 0; i < 8; ++i) v[i] = inb ? __builtin_nontemporal_load((const f32x4*)(sp + (size_t)i * N)) * 32.f : (f32x4){0.f, 0.f, 0.f, 0.f};
    if (scale) {
#pragma unroll
        for (int i = 0; i < 8; ++i) v[i] *= scale[k0 + lk + i];
    }
#pragma unroll
    for (int j = 0; j < 4; ++j) {
        const unsigned w0 = cvt4_fp8(v[0][j], v[1][j], v[2][j], v[3][j]), w1 = cvt4_fp8(v[4][j], v[5][j], v[6][j], v[7][j]);
        *(LAS unsigned*)(lds + (ln4 + j) * 132 + lk) = w0; *(LAS unsigned*)(lds + (ln4 + j) * 132 + lk + 4) = w1; }
    __syncthreads();
    const int n = t >> 2, kq = (t & 3) * 32;
    unsigned w[8];
#pragma unroll
    for (int q = 0; q < 8; ++q) w[q] = *(const LAS unsigned*)(lds + n * 132 + kq + q * 4);
    if (n0 + n < N) { unsigned char* d = dst + (size_t)e * drows * K + (size_t)(drow0 + n) * K + k0 + kq;
      u32x4 a = {w[0], w[1], w[2], w[3]}, b = {w[4], w[5], w[6], w[7]}; *(u32x4*)d = a; *(u32x4*)(d + 16) = b; }
    __syncthreads();
}
struct CvtD { const float* sp; const float* sc; unsigned char* d; int N; bool inb, stv; };
__device__ __forceinline__ void cvt8_desc(const float* __restrict__ src, int K, int N, unsigned char* __restrict__ dst, int drows, int mode, const float* __restrict__ scale, int T, int t, CvtD& q) {
    const int ntn = (N + 127) >> 7, tpe = (K >> 7) * ntn;
    const int e = T / tpe, rem = T - e * tpe, kt = rem / ntn, nt_ = rem - kt * ntn, n0 = nt_ * 128, k0 = kt * 128;
    int drow0 = n0;
    if (mode == 1) drow0 = (n0 >> 7) * 256;
    else if (mode == 2) drow0 = (n0 >> 7) * 256 + 128;
    else if (mode == 3) drow0 = n0 < 1536 ? n0 : (n0 < 2560 ? 1536 + ((n0 - 1536) >> 7) * 256 : 1536 + ((n0 - 2560) >> 7) * 256 + 128);
    const int lk = (t >> 5) * 8, ln4 = (t & 31) * 4;
    q.inb = (n0 + ln4) < N; q.N = N;
    q.sp = src + (size_t)e * K * N + (size_t)(k0 + lk) * N + (q.inb ? n0 + ln4 : 0);
    q.sc = scale ? scale + k0 + lk : nullptr;
    const int n = t >> 2, kq = (t & 3) * 32;
    q.stv = n0 + n < N; q.d = dst + (size_t)e * drows * K + (size_t)(drow0 + n) * K + k0 + kq;
}
__device__ __forceinline__ void cvt8_load(const CvtD& q, f32x4 (&v)[8]) {
#pragma unroll
    for (int i = 0; i < 8; ++i) v[i] = __builtin_nontemporal_load((const f32x4*)(q.sp + (size_t)i * q.N));
}
__device__ __forceinline__ void cvt8_finish(const CvtD& q, f32x4 (&v)[8], LAS unsigned char* lds, int t) {
    const int lk = (t >> 5) * 8, ln4 = (t & 31) * 4;
#pragma unroll
    for (int i = 0; i < 8; ++i) v[i] = q.inb ? v[i] * 32.f : (f32x4){0.f, 0.f, 0.f, 0.f};
    if (q.sc) {
#pragma unroll
        for (int i = 0; i < 8; ++i) v[i] *= q.sc[i];
    }
#pragma unroll
    for (int j = 0; j < 4; ++j) {
        const unsigned w0 = cvt4_fp8(v[0][j], v[1][j], v[2][j], v[3][j]), w1 = cvt4_fp8(v[4][j], v[5][j], v[6][j], v[7][j]);
        *(LAS unsigned*)(lds + (ln4 + j) * 132 + lk) = w0; *(LAS unsigned*)(lds + (ln4 + j) * 132 + lk + 4) = w1; }
    __syncthreads();
    const int n = t >> 2, kq = (t & 3) * 32;
    unsigned w[8];
#pragma unroll
    for (int qq = 0; qq < 8; ++qq) w[qq] = *(const LAS unsigned*)(lds + n * 132 + kq + qq * 4);
    if (q.stv) { u32x4 a = {w[0], w[1], w[2], w[3]}, b = {w[4], w[5], w[6], w[7]}; *(u32x4*)q.d = a; *(u32x4*)(q.d + 16) = b; }
    __syncthreads();
}
constexpr int CVT_ALL = 6144 + 960 + 944 + 6144, CVT_EAGER = CVT_ALL - (2304 + 768 + 384 + 840);
constexpr int P0_MOD = 768, P0_PAD = 48, P0_ROPE = 384, P0_ITEMS = P0_MOD + P0_PAD + P0_ROPE + CVT_EAGER;
__device__ __forceinline__ void cvt_item(const Params& p, int T, LAS unsigned char* lds, int t) {
    bf16_t* W = (bf16_t*)(p.ws + WS_W); unsigned char* W8 = (unsigned char*)W;
    if (T < 2048) { cvt_job_f8(p.in[17], 2048, 1024, W8 + W_GU0 * 2, 2048, 1, nullptr, T, lds, t); return; } T -= 2048;
    if (T < 2048) { cvt_job_f8(p.in[18], 2048, 1024, W8 + W_GU0 * 2, 2048, 2, nullptr, T, lds, t); return; } T -= 2048;
    if (T < 2048) { cvt_job_f8(p.in[19], 1024, 2048, W8 + W_DN0 * 2, 2048, 0, nullptr, T, lds, t); return; } T -= 2048;
    if (T < 448) { cvt_job_f8(p.in[7], 2048, 3584, W8 + W_IN0 * 2, 3584, 3, nullptr, T, lds, t); return; } T -= 448;
    if (T < 512) { cvt_job(p.in[14], 2048, 2048, W + W_OUT0, 2048, 0, nullptr, T, lds, t); return; } T -= 512;
    if (T < 272) { cvt_job_f8(p.in[23], 2048, 2112, W8 + W_DQKV * 2, 2304, 0, nullptr, T, lds, t); return; } T -= 272;
    if (T < 288) { cvt_job_f8(p.in[25], 1536, 3072, W8 + W_UQ * 2, 3072, 0, p.in[24], T, lds, t); return; } T -= 288;
    if (T < 128) { cvt_job_f8(p.in[27], 512, 4096, W8 + W_UKV * 2, 4096, 0, p.in[26], T, lds, t); return; } T -= 128;
    if (T < 256) { cvt_job_f8(p.in[28], 2048, 2048, W8 + W_OUT1 * 2, 2048, 0, nullptr, T, lds, t); return; } T -= 256;
    if (T < 2048) { cvt_job_f8(p.in[31], 2048, 1024, W8 + W_GU1 * 2, 2048, 1, nullptr, T, lds, t); return; } T -= 2048;
    if (T < 2048) { cvt_job_f8(p.in[32], 2048, 1024, W8 + W_GU1 * 2, 2048, 2, nullptr, T, lds, t); return; } T -= 2048;
    cvt_job_f8(p.in[33], 1024, 2048, W8 + W_DN1 * 2, 2048, 0, nullptr, T, lds, t);
}
__device__ __forceinline__ void cvt8_item_desc(const Params& p, int T, int t, CvtD& q) {
    unsigned char* W8 = (unsigned char*)(p.ws + WS_W);
    if (T < 2048) { cvt8_desc(p.in[17], 2048, 1024, W8 + W_GU0 * 2, 2048, 1, nullptr, T, t, q); return; } T -= 2048;
    if (T < 2048) { cvt8_desc(p.in[18], 2048, 1024, W8 + W_GU0 * 2, 2048, 2, nullptr, T, t, q); return; } T -= 2048;
    if (T < 2048) { cvt8_desc(p.in[19], 1024, 2048, W8 + W_DN0 * 2, 2048, 0, nullptr, T, t, q); return; } T -= 2048;
    if (T < 448) { cvt8_desc(p.in[7], 2048, 3584, W8 + W_IN0 * 2, 3584, 3, nullptr, T, t, q); return; } T -= 448 + 512;
    if (T < 272) { cvt8_desc(p.in[23], 2048, 2112, W8 + W_DQKV * 2, 2304, 0, nullptr, T, t, q); return; } T -= 272;
    if (T < 288) { cvt8_desc(p.in[25], 1536, 3072, W8 + W_UQ * 2, 3072, 0, p.in[24], T, t, q); return; } T -= 288;
    if (T < 128) { cvt8_desc(p.in[27], 512, 4096, W8 + W_UKV * 2, 4096, 0, p.in[26], T, t, q); return; } T -= 128;
    if (T < 256) { cvt8_desc(p.in[28], 2048, 2048, W8 + W_OUT1 * 2, 2048, 0, nullptr, T, t, q); return; } T -= 256;
    if (T < 2048) { cvt8_desc(p.in[31], 2048, 1024, W8 + W_GU1 * 2, 2048, 1, nullptr, T, t, q); return; } T -= 2048;
    if (T < 2048) { cvt8_desc(p.in[32], 2048, 1024, W8 + W_GU1 * 2, 2048, 2, nullptr, T, t, q); return; } T -= 2048;
    cvt8_desc(p.in[33], 1024, 2048, W8 + W_DN1 * 2, 2048, 0, nullptr, T, t, q);
}
__device__ __forceinline__ void cvt_tail(const Params& p, int lo, int hi, int first, LAS unsigned char* lds, int wv) {
    const int c = blockIdx.x, G = gridDim.x;
    if (c < first) return;
    const int t = TID_OF(wv), st = G - first;
    int T = lo + (c - first);
    if (T < hi) {
        CvtD qc, qn; f32x4 vc[8], vn[8];
        cvt8_item_desc(p, T, t, qc); cvt8_load(qc, vc);
        for (; T < hi; T += st) {
            const int Tn = T + st < hi ? T + st : T;
            cvt8_item_desc(p, Tn, t, qn); cvt8_load(qn, vn);
            cvt8_finish(qc, vc, lds, t);
            qc = qn;
#pragma unroll
            for (int i = 0; i < 8; ++i) vc[i] = vn[i];
        }
    }
}

__device__ __forceinline__ void phase_prep(const Params& p, LAS unsigned char* lds, int wv) {
    const int t = TID_OF(wv);
    bf16_t* W = (bf16_t*)(p.ws + WS_W);
    constexpr int CVT_BF0 = 6144 + 448, CVT_NBF = 512, P0_FIRST = P0_MOD + P0_PAD + P0_ROPE + CVT_NBF;
    for (int it = blockIdx.x; it < P0_FIRST; it += gridDim.x) {
        if (it < P0_MOD) {
            const int l = it / 384, rem = it - l * 384, kc = rem / 12, cc = rem - kc * 12;
            LAS float* sl = (LAS float*)lds;
            const float* w = p.in[l == 0 ? 4 : 20] + (size_t)(kc * 64) * 12288 + cc * 1024 + t * 2;
            f32x2 wv2[2][8];
#pragma unroll
            for (int j = 0; j < 8; ++j) wv2[0][j] = __builtin_nontemporal_load((const f32x2*)(w + (size_t)j * 12288));
            __syncthreads();
            for (int i = t; i < 9 * 64; i += NTHR) { const int r = i >> 6, k = kc * 64 + (i & 63); const float v = r < 8 ? p.in[1][r * D + k] : p.in[3][k]; sl[i] = v * sigmoid_f(v); }
            __syncthreads();
            float a0[9], a1[9];
#pragma unroll
            for (int r = 0; r < 9; ++r) { a0[r] = 0.f; a1[r] = 0.f; }
#pragma unroll
            for (int s8 = 0; s8 < 8; ++s8) {
                if (s8 + 1 < 8) {
#pragma unroll
                    for (int j = 0; j < 8; ++j) wv2[(s8 + 1) & 1][j] = __builtin_nontemporal_load((const f32x2*)(w + (size_t)((s8 + 1) * 8 + j) * 12288)); }
                __builtin_amdgcn_sched_barrier(0);
#pragma unroll
                for (int j = 0; j < 8; ++j)
#pragma unroll
                    for (int r = 0; r < 9; ++r) { const float s = sl[r * 64 + s8 * 8 + j]; a0[r] += s * wv2[s8 & 1][j].x; a1[r] += s * wv2[s8 & 1][j].y; }
            }
            float* mp = (float*)(p.ws + WS_MODP) + ((size_t)(l * 32 + kc) * 9) * 12288 + cc * 1024 + t * 2;
#pragma unroll
            for (int r = 0; r < 9; ++r) { f32x2 o; o.x = a0[r]; o.y = a1[r]; *(f32x2*)(mp + (size_t)r * 12288) = o; }
            __syncthreads();
        } else if (it < P0_MOD + P0_PAD) {
            const int i = (it - P0_MOD) * NTHR + t;
            u32x4 z = {0u, 0u, 0u, 0u};
            *(u32x4*)((unsigned char*)W + W_DQKV * 2 + (size_t)2112 * D + (size_t)i * 16) = z;
        } else if (it < P0_MOD + P0_PAD + P0_ROPE) {
            const int i = (it - P0_MOD - P0_PAD) * NTHR + t;
            float* rp = (float*)(p.ws + WS_ROPE);
            if (i < 2048 * 64) { const int s = i >> 6, j = i & 63; const float pos = j < 32 ? (float)(s >> 6) : (float)(s & 63);
                const float inv = powf(10000.f, -(float)(j & 31) / 32.f); const float ang = pos * inv;
                rp[i] = cosf(ang); rp[2048 * 64 + i] = sinf(ang); }
            else { const int i2 = i - 2048 * 64, s = i2 >> 5, j = i2 & 31; const float pos = j < 16 ? (float)(s >> 6) : (float)(s & 63);
                const float inv = powf(10000.f, -(float)(j & 15) / 16.f); const float ang = pos * inv;
                rp[2 * 2048 * 64 + i2] = cosf(ang); rp[2 * 2048 * 64 + 2048 * 32 + i2] = sinf(ang); }
        } else {
            cvt_item(p, CVT_BF0 + it - (P0_MOD + P0_PAD + P0_ROPE), lds, t);
        }
    }
    {
        constexpr int NJ = CVT_EAGER - CVT_NBF;
        const int G = gridDim.x; int j = (int)((blockIdx.x + G - (unsigned)(P0_FIRST % G)) % G);
        if (j < NJ) {
            CvtD qc, qn; f32x4 vc[8], vn[8];
            cvt8_item_desc(p, j < CVT_BF0 ? j : j + CVT_NBF, t, qc); cvt8_load(qc, vc);
            for (; j < NJ; j += G) {
                const int jn = j + G < NJ ? j + G : j;
                cvt8_item_desc(p, jn < CVT_BF0 ? jn : jn + CVT_NBF, t, qn); cvt8_load(qn, vn);
                cvt8_finish(qc, vc, lds, t);
                qc = qn;
#pragma unroll
                for (int i = 0; i < 8; ++i) vc[i] = vn[i];
            }
        }
    }
    __syncthreads();
}

__device__ __forceinline__ void phase_modreduce(const Params& p, int wv) {
    const float* mp = (const float*)(p.ws + WS_MODP); float* mod = (float*)(p.ws + WS_MOD);
    for (int i4 = blockIdx.x * NTHR + TID_OF(wv); i4 < 2 * 9 * 12288 / 4; i4 += gridDim.x * NTHR) {
        const int i = i4 * 4, l = i / (9 * 12288), rem = i - l * 9 * 12288, n = rem % 12288;
        f32x4 pv[32];
#pragma unroll
        for (int kc = 0; kc < 32; ++kc) pv[kc] = *(const f32x4*)(mp + (size_t)(l * 32 + kc) * 9 * 12288 + rem);
        f32x4 s = *(const f32x4*)(p.in[l == 0 ? 5 : 21] + n);
#pragma unroll
        for (int kc = 0; kc < 32; ++kc) s += pv[kc];
        *(f32x4*)(mod + i) = s;
    }
}

__device__ __forceinline__ void norm_mod_store(const f32x4 (&xv)[8], float rstd, const float* __restrict__ g, const float* __restrict__ sc, const float* __restrict__ sh, bf16_t* __restrict__ hrow, int lane) {
#pragma unroll
    for (int i = 0; i < 8; ++i) { const int k = i * 256 + lane * 4;
        const f32x4 gv = *(const f32x4*)(g + k), sv = *(const f32x4*)(sc + k), tv = *(const f32x4*)(sh + k);
        const f32x4 y = xv[i] * rstd * gv * (1.f + sv) + tv;
        u32x2 w; w.x = cvt_pk_bf16(y[0], y[1]); w.y = cvt_pk_bf16(y[2], y[3]); *(u32x2*)(hrow + k) = w; }
}
__device__ __forceinline__ float row_sumsq(const f32x4 (&xv)[8]) {
    float ss = 0.f;
#pragma unroll
    for (int i = 0; i < 8; ++i) ss += xv[i][0] * xv[i][0] + xv[i][1] * xv[i][1] + xv[i][2] * xv[i][2] + xv[i][3] * xv[i][3];
    return wave_sum(ss);
}

__device__ __forceinline__ void phase_norm1_l0(const Params& p, int wv) {
    const int lane = lane_id(), wid = wv;
    const float* mod = mod_ptr(p, 0); bf16_t* H = (bf16_t*)(p.ws + WS_H);
    const int nw = gridDim.x * 8, gw = blockIdx.x * 8 + wid, grp = gw % 9, wi = gw / 9, nwi = (nw - grp + 8) / 9;
    f32x4 gm[8], tv[8];
    { const float* sc = mod + (size_t)grp * 12288 + 1 * D; const float* sh = mod + (size_t)grp * 12288 + 0 * D;
#pragma unroll
      for (int i = 0; i < 8; ++i) { const int k = i * 256 + lane * 4; gm[i] = *(const f32x4*)(p.in[6] + k) * (1.f + *(const f32x4*)(sc + k)); tv[i] = *(const f32x4*)(sh + k); } }
    const float* srcb = grp < 8 ? p.in[0] + (size_t)grp * SEQ * D : p.in[2];
#define P2_ROW(i_) (grp < 8 ? grp * RPB + CL + (i_) : ((i_) >> 8) * RPB + ((i_) & 255))
    f32x4 xv[8];
#pragma unroll
    for (int i = 0; i < 8; ++i) xv[i] = *(const f32x4*)(srcb + (size_t)wi * D + i * 256 + lane * 4);
    for (int it = wi; it < 2048; it += nwi) {
        const int itn = it + nwi < 2048 ? it + nwi : it; f32x4 xn[8];
#pragma unroll
        for (int i = 0; i < 8; ++i) xn[i] = *(const f32x4*)(srcb + (size_t)itn * D + i * 256 + lane * 4);
        const float rstd = rsqrtf(row_sumsq(xv) * (1.f / D) + EPS);
        unsigned char* hrow = (unsigned char*)H + (size_t)P2_ROW(it) * D;
#pragma unroll
        for (int i = 0; i < 8; ++i) { const int k = i * 256 + lane * 4; const f32x4 y = xv[i] * rstd * gm[i] + tv[i];
            *(unsigned*)(hrow + k) = cvt4_fp8(y[0], y[1], y[2], y[3]); }
#pragma unroll
        for (int i = 0; i < 8; ++i) xv[i] = xn[i];
    }
#undef P2_ROW
}

__device__ __forceinline__ void phase_kprep(const Params& p, int wv) {
    const int lane = lane_id(), wid = wv;
    const bf16_t* proj = (const bf16_t*)(p.ws + WS_R3 + R3_PROJ);
    const float* tc = (const float*)(p.ws + WS_ROPE); const float* tsn = tc + 2048 * 64;
    const float kg1 = p.in[9][lane], kg2 = p.in[9][64 + lane];
    const int nw = gridDim.x * 8;
    for (int rb = blockIdx.x * 8 + wid; rb < M; rb += 3 * nw) {
        float xa[3][2], xb[3][2], cc[3], ss[3];
#pragma unroll
        for (int u = 0; u < 3; ++u) { const int r = rb + u * nw;
            if (r < M) { const int b = r / RPB, o = r - b * RPB, s = o >= CL ? o - CL : 0; const bf16_t* prow = proj + (size_t)r * QKVW + 1024;
#pragma unroll
                for (int kh = 0; kh < 2; ++kh) { xa[u][kh] = bf2f(prow[kh * 128 + lane]); xb[u][kh] = bf2f(prow[kh * 128 + 64 + lane]); }
                cc[u] = tc[(size_t)s * 64 + lane]; ss[u] = tsn[(size_t)s * 64 + lane]; } }
#pragma unroll
        for (int u = 0; u < 3; ++u) { const int r = rb + u * nw;
            if (r < M) { const int b = r / RPB, o = r - b * RPB; const bool lat = o >= CL;
#pragma unroll
                for (int kh = 0; kh < 2; ++kh) {
                    const float x1 = xa[u][kh], x2 = xb[u][kh];
                    const float rstd = rsqrtf(wave_sum(x1 * x1 + x2 * x2) * (1.f / 128.f) + EPS);
                    float y1 = x1 * rstd * kg1, y2 = x2 * rstd * kg2;
                    if (lat) { const float c = cc[u], sn = ss[u]; const float o1 = y1 * c - y2 * sn, o2 = y1 * sn + y2 * c; y1 = o1; y2 = o2; }
                    unsigned char* k8 = (unsigned char*)(p.ws + WS_K8G) + (size_t)r * 256 + kh * 128;
                    k8[lane] = (unsigned char)(cvt4_fp8(y1, 0.f, 0.f, 0.f) & 0xffu); k8[64 + lane] = (unsigned char)(cvt4_fp8(y2, 0.f, 0.f, 0.f) & 0xffu);
                } } }
    }
}

__device__ __forceinline__ void conv_item(const Params& p, int j, LAS unsigned char* lds, int wv) {
    const int t = TID_OF(wv);
    const bf16_t* ug = (const bf16_t*)(p.ws + WS_R3 + R3_UG); bf16_t* cat = (bf16_t*)(p.ws + WS_CAT);
    const int row0 = j * 32, b = row0 / RPB, o = row0 - b * RPB;
    const int seq_lo = o < CL ? b * RPB : b * RPB + CL, seq_hi = o < CL ? b * RPB + CL : (b + 1) * RPB;
    f32x2 w[31];
#pragma unroll
    for (int jj = 0; jj < 31; ++jj) w[jj] = *(const f32x2*)(p.in[10] + jj * 1024 + 2 * t);
    const f32x2 cbv = *(const f32x2*)(p.in[11] + 2 * t), lng = *(const f32x2*)(p.in[12] + 2 * t), lnb = *(const f32x2*)(p.in[13] + 2 * t);
    { u32x4 tv[16];
#pragma unroll
      for (int q = 0; q < 16; ++q) { const int c = t + q * NTHR, rr = (c >> 7) < 62 ? (c >> 7) : 61, cc = (c & 127) * 8, gr = row0 - 15 + rr;
          const int grc = gr < seq_lo ? seq_lo : (gr >= seq_hi ? seq_hi - 1 : gr); tv[q] = *(const u32x4*)(ug + (size_t)grc * 1024 + cc); }
#pragma unroll
      for (int q = 0; q < 16; ++q) { const int c = t + q * NTHR, rr = c >> 7, cc = (c & 127) * 8, gr = row0 - 15 + rr;
          const bool in = gr >= seq_lo && gr < seq_hi; const u32x4 v = in ? tv[q] : (u32x4){0u, 0u, 0u, 0u};
          if (c < 62 * 128) *(LAS u32x4*)(lds + rr * 2048 + cc * 2) = v; } }
    __syncthreads();
    f32x2 a[32];
#pragma unroll
    for (int k = 0; k < 32; ++k) a[k] = cbv;
#pragma unroll
    for (int rr = 0; rr < 62; ++rr) { const unsigned v = *(const LAS unsigned*)(lds + rr * 2048 + t * 4); const f32x2 x = {bf_lo(v), bf_hi(v)};
#pragma unroll
        for (int tok = (rr - 30 > 0 ? rr - 30 : 0); tok <= (rr < 31 ? rr : 31); ++tok) a[tok] += w[rr - tok] * x; }
    __syncthreads();
    LAS float* part = (LAS float*)lds;
#pragma unroll
    for (int k = 0; k < 32; ++k) { part[k * 512 + t] = a[k].x + a[k].y; part[(32 + k) * 512 + t] = a[k].x * a[k].x + a[k].y * a[k].y; }
    __syncthreads();
    LAS float* stats = (LAS float*)(lds + IDX_OFF);
    { const int tok = t >> 4, sub = t & 15; float s1 = 0.f, s2 = 0.f;
#pragma unroll 8
      for (int k = 0; k < 32; ++k) { const int kk = (k + sub) & 31; s1 += part[tok * 512 + sub * 32 + kk]; s2 += part[(32 + tok) * 512 + sub * 32 + kk]; }
#pragma unroll
      for (int of = 8; of; of >>= 1) { s1 += __shfl_xor(s1, of); s2 += __shfl_xor(s2, of); }
      const float mean = s1 * (1.f / 1024.f), var = s2 * (1.f / 1024.f) - mean * mean;
      if (sub == 0) { stats[tok * 2] = mean; stats[tok * 2 + 1] = rsqrtf(fmaxf(var, 0.f) + EPS); } }
    __syncthreads();
    { const f32x2 gv = lng, bv = lnb;
#pragma unroll
      for (int k = 0; k < 32; ++k) { const float mean = stats[k * 2], rstd = stats[k * 2 + 1];
          const float y0 = (a[k].x - mean) * rstd * gv.x + bv.x, y1 = (a[k].y - mean) * rstd * gv.y + bv.y;
          *(unsigned*)(cat + (size_t)(row0 + k) * D + 1024 + 2 * t) = cvt_pk_bf16(silu_f(y0), silu_f(y1)); } }
    __syncthreads();
}

__device__ __forceinline__ void phase_attn0_conv(const Params& p, LAS unsigned char* lds, int wv) {
    const bf16_t* proj = (const bf16_t*)(p.ws + WS_R3 + R3_PROJ); bf16_t* cat = (bf16_t*)(p.ws + WS_CAT);
    const float* tc = (const float*)(p.ws + WS_ROPE); const float* tsn = tc + 2048 * 64;
#ifndef NO_ATT0
    for (int it = blockIdx.x; it < 576; it += gridDim.x) {
        {
            int b, hq, qb;
            if (it < 512) { b = it & 7; const int j = it >> 3; hq = j >> 3; qb = 1 + (j & 7); } else { const int i2 = it - 512; b = i2 & 7; hq = i2 >> 3; qb = 0; }
            const size_t row0 = (size_t)b * RPB, qrow0 = row0 + qb * 256; const int kvh = hq >> 2;
            at::attn_body8<128, 0, QKVW, 256, D, false, 2>(proj + qrow0 * QKVW + hq * 128, (const unsigned char*)(p.ws + WS_K8G) + row0 * 256 + kvh * 128, nullptr, (const unsigned char*)(p.ws + WS_VT8G) + (size_t)(b * 2 + kvh) * 128 * RPB,
                                     cat + qrow0 * D + hq * 128, qb == 0 ? CL : RPB, (LAS char*)lds, qb > 0, (qb - 1) * 256, p.in[8], tc, tsn, wv);
        }
    }
#endif
#ifndef NO_CONV
    for (int it = (int)((blockIdx.x + 64u) % gridDim.x); it < 576; it += gridDim.x) conv_item(p, it, lds, wv);
#endif
}

typedef _Float16 half8 __attribute__((ext_vector_type(8)));
typedef _Float16 half2v __attribute__((ext_vector_type(2)));
__device__ __forceinline__ unsigned pk_f16(float a, float b) { const half2v h = __builtin_convertvector((f32x2){a, b}, half2v); return __builtin_bit_cast(unsigned, h); }
__device__ __forceinline__ void phase_n2router(const Params& p, int l, LAS unsigned char* lds, int wv) {
    const int lane = lane_id(), wid = wv, t = wv * 64 + lane, fr = lane & 15, fq = lane >> 4;
    const float* router = p.in[l == 0 ? 16 : 30]; const float* g2 = p.in[l == 0 ? 15 : 29];
    const float* mod = mod_ptr(p, l); const bf16_t* xres = (const bf16_t*)(p.ws + WS_XRES); unsigned char* H8 = (unsigned char*)(p.ws + WS_H);
    float* aff = (float*)(p.ws + WS_AFF); int* tokslot = (int*)(p.ws + WS_TOKSLOT);
    constexpr int RT_PITCH = 4112;
    constexpr int GM_OFF = 16 * RT_PITCH + 256 - (16 * RT_PITCH) % 256, TV_OFF = GM_OFF + 8192, SS_OFF = TV_OFF + 8192, PP_OFF = SS_OFF + 512;
    static_assert(PP_OFF + 8192 <= LDS_BYTES, "router LDS");
    { f32x4 ra[8], rb[8];
#pragma unroll
      for (int q = 0; q < 8; ++q) { const int i = t + q * NTHR, kp = i >> 2, e4 = (i & 3) * 4;
          ra[q] = *(const f32x4*)(router + (size_t)(2 * kp) * 16 + e4); rb[q] = *(const f32x4*)(router + (size_t)(2 * kp + 1) * 16 + e4); }
#pragma unroll
      for (int q = 0; q < 8; ++q) { const int i = t + q * NTHR, kp = i >> 2, e4 = (i & 3) * 4;
#pragma unroll
          for (int j = 0; j < 4; ++j) *(LAS unsigned*)(lds + (e4 + j) * RT_PITCH + kp * 4) = pk_f16(ra[q][j], rb[q][j]); } }
    LAS float* SS = (LAS float*)(lds + SS_OFF); LAS float* PP = (LAS float*)(lds + PP_OFF);
    const int c = blockIdx.x, G = gridDim.x, nblk = l == 0 ? M / 16 : NB * SEQ / 16;
    const int b0 = (int)((long)c * nblk / G), b1 = (int)((long)(c + 1) * nblk / G);
#define N2_ROW0(blk_) (l == 0 ? (blk_) * 16 : ((blk_) >> 7) * RPB + CL + ((blk_) & 127) * 16)
    u32x4 xs[8];
    if (b0 < b1) { const bf16_t* src = xres + (size_t)(N2_ROW0(b0) + fr) * D + 256 * wid + 8 * fq;
#pragma unroll
        for (int s = 0; s < 8; ++s) xs[s] = *(const u32x4*)(src + 32 * s); }
    int cur_grp = -1;
    for (int blk = b0; blk < b1; ++blk) {
        const int row0 = N2_ROW0(blk), bb = row0 / RPB, oo = row0 - bb * RPB, grp = (l == 0 && oo < CL) ? 8 : bb;
        u32x4 xn[8];
        { const int bn = blk + 1 < b1 ? blk + 1 : blk; const bf16_t* src = xres + (size_t)(N2_ROW0(bn) + fr) * D + 256 * wid + 8 * fq;
#pragma unroll
            for (int s = 0; s < 8; ++s) xn[s] = *(const u32x4*)(src + 32 * s); }
        if (grp != cur_grp) { cur_grp = grp;
            const float* sc = mod + (size_t)grp * 12288 + 4 * D; const float* sh = mod + (size_t)grp * 12288 + 3 * D; const int k = t * 4;
            *(LAS f32x4*)(lds + GM_OFF + k * 4) = *(const f32x4*)(g2 + k) * (1.f + *(const f32x4*)(sc + k)); *(LAS f32x4*)(lds + TV_OFF + k * 4) = *(const f32x4*)(sh + k); }
        float ss = 0.f;
#pragma unroll
        for (int s = 0; s < 8; ++s)
#pragma unroll
            for (int q = 0; q < 4; ++q) { const float lo = __uint_as_float(xs[s][q] << 16), hi = __uint_as_float(xs[s][q] & 0xffff0000u); ss += lo * lo + hi * hi; }
        ss += __shfl_xor(ss, 16); ss += __shfl_xor(ss, 32);
        if (fq == 0) SS[wid * 16 + fr] = ss;
        __syncthreads();
        float tot = 0.f;
#pragma unroll
        for (int w = 0; w < 8; ++w) tot += SS[w * 16 + fr];
        const float rstd = rsqrtf(tot * (1.f / D) + EPS);
        f32x4 acc = {0.f, 0.f, 0.f, 0.f};
        unsigned char* hrow = H8 + (size_t)(row0 + fr) * D + 256 * wid + 8 * fq;
#pragma unroll
        for (int s = 0; s < 8; ++s) { const int kk = 256 * wid + 32 * s + 8 * fq;
            const f32x4 g0 = *(const LAS f32x4*)(lds + GM_OFF + kk * 4), g1 = *(const LAS f32x4*)(lds + GM_OFF + kk * 4 + 16), t0 = *(const LAS f32x4*)(lds + TV_OFF + kk * 4), t1 = *(const LAS f32x4*)(lds + TV_OFF + kk * 4 + 16);
            f32x4 y0, y1;
            y0[0] = __uint_as_float(xs[s][0] << 16); y0[1] = __uint_as_float(xs[s][0] & 0xffff0000u); y0[2] = __uint_as_float(xs[s][1] << 16); y0[3] = __uint_as_float(xs[s][1] & 0xffff0000u);
            y1[0] = __uint_as_float(xs[s][2] << 16); y1[1] = __uint_as_float(xs[s][2] & 0xffff0000u); y1[2] = __uint_as_float(xs[s][3] << 16); y1[3] = __uint_as_float(xs[s][3] & 0xffff0000u);
            y0 = y0 * rstd * g0 + t0; y1 = y1 * rstd * g1 + t1;
            *(u32x2*)(hrow + 32 * s) = (u32x2){cvt4_fp8(y0[0], y0[1], y0[2], y0[3]), cvt4_fp8(y1[0], y1[1], y1[2], y1[3])};
            const u32x4 aw = {pk_f16(y0[0], y0[1]), pk_f16(y0[2], y0[3]), pk_f16(y1[0], y1[1]), pk_f16(y1[2], y1[3])};
            const half8 bf = *(const LAS half8*)(lds + fr * RT_PITCH + kk * 2);
            acc = __builtin_amdgcn_mfma_f32_16x16x32_f16(__builtin_bit_cast(half8, aw), bf, acc, 0, 0, 0); }
#pragma unroll
        for (int r = 0; r < 4; ++r) PP[(wid * 16 + 4 * fq + r) * 16 + fr] = acc[r];
        __syncthreads();
        if (t < 256) { const int row = t >> 4, e = t & 15; float lg = 0.f;
#pragma unroll
            for (int w = 0; w < 8; ++w) lg += PP[(w * 16 + row) * 16 + e];
            float mx = lg;
#pragma unroll
            for (int o = 1; o < 16; o <<= 1) mx = fmaxf(mx, __shfl_xor(mx, o));
            const float ex = expf(lg - mx); float sum = ex;
#pragma unroll
            for (int o = 1; o < 16; o <<= 1) sum += __shfl_xor(sum, o);
            aff[(size_t)(row0 + row) * 16 + e] = ex / sum; tokslot[(size_t)(row0 + row) * 16 + e] = -1; }
#pragma unroll
        for (int s = 0; s < 8; ++s) xs[s] = xn[s];
    }
#undef N2_ROW0
    __syncthreads();
}

__device__ __forceinline__ int block_count(LAS int* cnt, int par, bool f0, bool f1, bool f2, bool f3, int wid, int lane) {
    const int c = __popcll(__ballot(f0)) + __popcll(__ballot(f1)) + __popcll(__ballot(f2)) + __popcll(__ballot(f3));
    if (lane == 0) cnt[par * 8 + wid] = c;
    __syncthreads();
    int tot = 0;
#pragma unroll
    for (int w = 0; w < 8; ++w) tot += cnt[par * 8 + w];
    return tot;
}
__device__ __forceinline__ int block_prefix(LAS int* cnt, int par, bool f0, bool f1, bool f2, bool f3, int wid, int lane) {
    const unsigned long long lt = (1ull << lane) - 1ull;
    const unsigned long long b0 = __ballot(f0), b1 = __ballot(f1), b2 = __ballot(f2), b3 = __ballot(f3);
    const int below = __popcll(b0 & lt) + __popcll(b1 & lt) + __popcll(b2 & lt) + __popcll(b3 & lt);
    const int wtot = __popcll(b0) + __popcll(b1) + __popcll(b2) + __popcll(b3);
    if (lane == 0) cnt[par * 8 + wid] = wtot;
    __syncthreads();
    int base = 0;
#pragma unroll
    for (int w = 0; w < 8; ++w) base += (w < wid) ? cnt[par * 8 + w] : 0;
    return base + below;
}
__device__ __forceinline__ void phase_topk(const Params& p, int l, LAS unsigned char* lds, int wv) {
    const int lane = lane_id(), wid = wv, t = wv * 64 + lane;
    const float* aff = (const float*)(p.ws + WS_AFF); int* tokslot = (int*)(p.ws + WS_TOKSLOT); int* rowidx = (int*)(p.ws + WS_ROWIDX); float* gate = (float*)(p.ws + WS_GATE);
    const int nitems = l == 0 ? 256 : 128, rpg = l == 0 ? 2304 : 2048;
    LAS int* cnt = (LAS int*)lds;
    for (int it = blockIdx.x; it < nitems; it += gridDim.x) {
        const int set = it >> 4, e = it & 15; int b, n, cap, row0, sbase;
        if (set < 8) { b = set; n = SEQ; cap = 256; row0 = b * RPB + CL; sbase = b * 256; } else { b = set - 8; n = CL; cap = 32; row0 = b * RPB; sbase = 2048 + b * 32; }
        unsigned key[4]; bool valid[4];
#pragma unroll
        for (int q = 0; q < 4; ++q) { const int i = t * 4 + q; valid[q] = i < n; key[q] = valid[q] ? __float_as_uint(aff[(size_t)(row0 + i) * 16 + e]) : 0u; }
        unsigned K = 0u; int par = 0;
        for (int bit = 30; bit >= 0; --bit) {
            const unsigned cand = K | (1u << bit);
            const int c = block_count(cnt, par, valid[0] && key[0] >= cand, valid[1] && key[1] >= cand, valid[2] && key[2] >= cand, valid[3] && key[3] >= cand, wid, lane);
            par ^= 1;
            if (c >= cap) K = cand;
        }
        const int ngt = block_count(cnt, par, valid[0] && key[0] > K, valid[1] && key[1] > K, valid[2] && key[2] > K, valid[3] && key[3] > K, wid, lane); par ^= 1;
        const int need_eq = cap - ngt;
        bool eq[4], sel[4];
#pragma unroll
        for (int q = 0; q < 4; ++q) eq[q] = valid[q] && key[q] == K;
        int pe = block_prefix(cnt, par, eq[0], eq[1], eq[2], eq[3], wid, lane); par ^= 1;
#pragma unroll
        for (int q = 0; q < 4; ++q) { sel[q] = valid[q] && (key[q] > K || (eq[q] && pe < need_eq)); pe += eq[q] ? 1 : 0; }
        int ps = block_prefix(cnt, par, sel[0], sel[1], sel[2], sel[3], wid, lane); par ^= 1;
#pragma unroll
        for (int q = 0; q < 4; ++q) {
            if (sel[q]) { const int i = t * 4 + q, slot = sbase + ps; rowidx[e * rpg + slot] = row0 + i; gate[e * rpg + slot] = __uint_as_float(key[q]); tokslot[(size_t)(row0 + i) * 16 + e] = slot; ++ps; }
        }
        __syncthreads();
    }
    __syncthreads();
}

__device__ __forceinline__ float f8_to_f32(unsigned w, int byte) { float r;
    if (byte == 0) asm("v_cvt_f32_fp8 %0, %1 src0_sel:BYTE_0" : "=v"(r) : "v"(w)); else if (byte == 1) asm("v_cvt_f32_fp8 %0, %1 src0_sel:BYTE_1" : "=v"(r) : "v"(w));
    else if (byte == 2) asm("v_cvt_f32_fp8 %0, %1 src0_sel:BYTE_2" : "=v"(r) : "v"(w)); else asm("v_cvt_f32_fp8 %0, %1 src0_sel:BYTE_3" : "=v"(r) : "v"(w));
    return r; }
__device__ __forceinline__ void phase_combine(const Params& p, int l, int wv) {
    const int lane = lane_id(), wid = wv;
    bf16_t* xres = (bf16_t*)(p.ws + WS_XRES);
    const int* tokslot = (const int*)(p.ws + WS_TOKSLOT); const unsigned char* y = (const unsigned char*)(p.ws + WS_Y); const int rpg = l == 0 ? 2304 : 2048;
    const int nw = gridDim.x * 8, gw = blockIdx.x * 8 + wid, ngrp = l == 0 ? 9 : 8, grp = gw % ngrp, wi = gw / ngrp, nwi = (nw - grp + ngrp - 1) / ngrp;
    f32x4 ga[8], gm[8], tv[8];
    { const float* mod = mod_ptr(p, l); const float* mod1 = mod_ptr(p, 1);
#pragma unroll
      for (int i = 0; i < 8; ++i) { const int k = i * 256 + lane * 4; ga[i] = *(const f32x4*)(mod + (size_t)grp * 12288 + 5 * D + k) * (1.f / 32.f);
          if (l == 0) { gm[i] = *(const f32x4*)(p.in[22] + k) * (1.f + *(const f32x4*)(mod1 + (size_t)grp * 12288 + 1 * D + k)); tv[i] = *(const f32x4*)(mod1 + (size_t)grp * 12288 + 0 * D + k); }
          else { gm[i] = *(const f32x4*)(p.in[34] + k); tv[i] = (f32x4){0.f, 0.f, 0.f, 0.f}; } } }
#define CB_ROW(i_) (grp < 8 ? grp * RPB + CL + (i_) : ((i_) >> 8) * RPB + ((i_) & 255))
    f32x4 xv[8]; int myslot;
    { const int r = CB_ROW(wi);
#pragma unroll
      for (int i = 0; i < 8; ++i) xv[i] = bf4_to_f32(*(const u32x2*)(xres + (size_t)r * D + i * 256 + lane * 4));
      myslot = tokslot[(size_t)r * 16 + (lane & 15)]; }
    for (int it = wi; it < 2048; it += nwi) {
        const int r = CB_ROW(it), itn = it + nwi < 2048 ? it + nwi : it; u32x2 xn[8]; int nslot;
        { const int rn = CB_ROW(itn);
#pragma unroll
            for (int i = 0; i < 8; ++i) xn[i] = *(const u32x2*)(xres + (size_t)rn * D + i * 256 + lane * 4);
            nslot = tokslot[(size_t)rn * 16 + (lane & 15)]; }
        f32x4 ys[8];
#pragma unroll
        for (int i = 0; i < 8; ++i) ys[i] = (f32x4){0.f, 0.f, 0.f, 0.f};
        unsigned act = (unsigned)(__ballot(myslot >= 0) & 0xFFFFull);
        while (act) {
            const int e0 = __builtin_ctz(act); act &= act - 1u;
            const bool h1 = act != 0u; const int e1 = h1 ? __builtin_ctz(act) : 0; if (h1) act &= act - 1u;
            const bool h2 = act != 0u; const int e2 = h2 ? __builtin_ctz(act) : 0; if (h2) act &= act - 1u;
            const bool h3 = act != 0u; const int e3 = h3 ? __builtin_ctz(act) : 0; if (h3) act &= act - 1u;
            unsigned w0[8], w1[8], w2[8], w3[8];
#define CB_LOAD(W_, E_) { const unsigned char* yrow = y + ((size_t)(E_) * rpg + __builtin_amdgcn_readlane(myslot, (E_))) * D; \
                _Pragma("unroll") for (int i = 0; i < 8; ++i) W_[i] = *(const unsigned*)(yrow + i * 256 + lane * 4); }
#define CB_ACC(W_) { _Pragma("unroll") for (int i = 0; i < 8; ++i) { ys[i][0] += f8_to_f32(W_[i], 0); ys[i][1] += f8_to_f32(W_[i], 1); ys[i][2] += f8_to_f32(W_[i], 2); ys[i][3] += f8_to_f32(W_[i], 3); } }
            CB_LOAD(w0, e0)
            if (h1) CB_LOAD(w1, e1)
            if (h2) CB_LOAD(w2, e2)
            if (h3) CB_LOAD(w3, e3)
            CB_ACC(w0)
            if (h1) CB_ACC(w1)
            if (h2) CB_ACC(w2)
            if (h3) CB_ACC(w3)
#undef CB_LOAD
#undef CB_ACC
        }
#pragma unroll
        for (int i = 0; i < 8; ++i) xv[i] += ga[i] * ys[i];
        const float rstd = rsqrtf(row_sumsq(xv) * (1.f / D) + EPS);
        if (l == 0) {
            bf16_t* xrow = xres + (size_t)r * D; unsigned char* hrow = (unsigned char*)(p.ws + WS_H) + (size_t)r * D;
#pragma unroll
            for (int i = 0; i < 8; ++i) { const int k = i * 256 + lane * 4; *(u32x2*)(xrow + k) = (u32x2){cvt_pk_bf16(xv[i][0], xv[i][1]), cvt_pk_bf16(xv[i][2], xv[i][3])};
                const f32x4 yv = xv[i] * rstd * gm[i] + tv[i]; *(unsigned*)(hrow + k) = cvt4_fp8(yv[0], yv[1], yv[2], yv[3]); }
        } else {
            float* orow = p.out + (size_t)(grp * SEQ + it) * D;
#pragma unroll
            for (int i = 0; i < 8; ++i) { const int k = i * 256 + lane * 4; __builtin_nontemporal_store(xv[i] * rstd * gm[i], (f32x4*)(orow + k)); }
        }
#pragma unroll
        for (int i = 0; i < 8; ++i) xv[i] = bf4_to_f32(xn[i]);
        myslot = nslot;
    }
#undef CB_ROW
}

__device__ __forceinline__ float sumsq_f8x4(unsigned w) { const float a = f8_to_f32(w, 0), b = f8_to_f32(w, 1), c = f8_to_f32(w, 2), d = f8_to_f32(w, 3); return a * a + b * b + c * c + d * d; }
__device__ __forceinline__ void phase_l1prep(const Params& p, int wv) {
    const int lane = lane_id(), wid = wv;
    const unsigned char* z = (const unsigned char*)(p.ws + WS_R3 + R3_Z); float* rq = (float*)(p.ws + WS_RSTDQ); float* rkv = (float*)(p.ws + WS_RSTDKV); unsigned char* kpe = (unsigned char*)(p.ws + WS_KPE);
    const float* tc = (const float*)(p.ws + WS_ROPE) + 2 * 2048 * 64; const float* tsn = tc + 2048 * 32;
    const int nw = gridDim.x * 8;
    for (int rb = blockIdx.x * 8 + wid; rb < M; rb += 3 * nw) {
        u32x2 wkv[3], wq[3][3]; unsigned wpe[3]; f32x4 cs[3], sn[3];
#pragma unroll
        for (int u = 0; u < 3; ++u) { const int r = rb + u * nw;
            if (r < M) { const int b = r / RPB, o = r - b * RPB, s = o >= CL ? o - CL : 0; const unsigned char* zr = z + (size_t)r * ZW;
                wkv[u] = *(const u32x2*)(zr + QLORA + lane * 8);
#pragma unroll
                for (int i = 0; i < 3; ++i) wq[u][i] = *(const u32x2*)(zr + i * 512 + lane * 8);
                wpe[u] = *(const unsigned*)(zr + 2048 + (lane & 15) * 4);
                cs[u] = *(const f32x4*)(tc + (size_t)s * 32 + (lane & 7) * 4); sn[u] = *(const f32x4*)(tsn + (size_t)s * 32 + (lane & 7) * 4); } }
#pragma unroll
        for (int u = 0; u < 3; ++u) { const int r = rb + u * nw;
            if (r < M) { const int b = r / RPB, o = r - b * RPB; const bool lat = o >= CL;
                { float ss = sumsq_f8x4(wkv[u].x) + sumsq_f8x4(wkv[u].y);
                  ss = wave_sum(ss); if (lane == 0) rkv[r] = rsqrtf(ss * (1.f / KVLORA) + EPS); }
                if (lat) { float ss = 0.f;
#pragma unroll
                  for (int i = 0; i < 3; ++i) ss += sumsq_f8x4(wq[u][i].x) + sumsq_f8x4(wq[u][i].y);
                  ss = wave_sum(ss); if (lane == 0) rq[r] = rsqrtf(ss * (1.f / QLORA) + EPS); }
                { const unsigned wqp = wpe[u];
                  float x1[4], x2[4];
#pragma unroll
                  for (int q = 0; q < 4; ++q) x1[q] = f8_to_f32(wqp, q);
#pragma unroll
                  for (int q = 0; q < 4; ++q) x2[q] = __shfl(x1[q], (lane & 7) + 8);
                  if (lane < 8) {
#pragma unroll
                      for (int q = 0; q < 4; ++q) { const int i = lane * 4 + q; float a = x1[q], c2 = x2[q];
                          if (lat) { const float c = cs[u][q], sv = sn[u][q]; const float o1 = a * c - c2 * sv, o2 = a * sv + c2 * c; a = o1; c2 = o2; }
                          kpe[(size_t)r * 64 + i] = (unsigned char)(cvt4_fp8(a, 0.f, 0.f, 0.f) & 0xffu); kpe[(size_t)r * 64 + 32 + i] = (unsigned char)(cvt4_fp8(c2, 0.f, 0.f, 0.f) & 0xffu); } } }
            } }
    }
}

__device__ __forceinline__ void phase_attn1(const Params& p, LAS unsigned char* lds, int wv) {
    const bf16_t* q1 = (const bf16_t*)(p.ws + WS_R3 + R3_Q1); bf16_t* cat = (bf16_t*)(p.ws + WS_CAT);
    const float* tc = (const float*)(p.ws + WS_ROPE) + 2 * 2048 * 64; const float* tsn = tc + 2048 * 32;
    for (int it = blockIdx.x; it < 1024; it += gridDim.x) {
        const int b = it & 7, j = it >> 3, h = j >> 3, qb = 1 + (j & 7);
        const size_t row0 = (size_t)b * RPB, qrow0 = row0 + qb * 256, lrow0 = (size_t)b * SEQ + (qb - 1) * 256;
        at::attn_body8<192, 1, QW, 2048, D, true, 2>(q1 + lrow0 * QW + h * 192, (const unsigned char*)(p.ws + WS_K8N) + row0 * 2048 + h * 128, (const unsigned char*)(p.ws + WS_KPE) + row0 * 64, (const unsigned char*)(p.ws + WS_VT8N) + (size_t)(b * 16 + h) * 128 * RPB,
                                 (bf16_t*)((unsigned char*)cat + qrow0 * D + h * 128), RPB, (LAS char*)lds, true, (qb - 1) * 256, nullptr, tc, tsn, wv);
    }
}

__global__ void __launch_bounds__(NTHR, 2) mega(Params p) {
    extern __shared__ __attribute__((aligned(16))) unsigned char lds_raw[];
    LAS unsigned char* lds = (LAS unsigned char*)lds_raw;
    const int wv = __builtin_amdgcn_readfirstlane((int)(threadIdx.x >> 6));
    if (wv == 0) ((LAS unsigned*)(lds + MISC_OFF))[lane_id()] = 0u;
    __syncthreads();
    const bool multi = (p.ph_hi - p.ph_lo) > 1;
    XcdBarrier bar; bar.bar = (unsigned*)(p.ws + WS_CTL); bar.x = 0; bar.st = (volatile LAS unsigned*)(lds + MISC_OFF);
    if (multi) bar = xcd_barrier_post((unsigned*)(p.ws + WS_CTL), (volatile LAS unsigned*)(lds + MISC_OFF), wv);
#ifndef PH_MASK
#define PH_MASK 0xFFFFFFFFu
#endif
#define IN(k) ((((PH_MASK) >> (k)) & 1u) && p.ph_lo <= (k) && (k) < p.ph_hi)
#define SEAM(k) do { if (IN(k) && IN((k) + 1)) xcd_barrier(bar, wv); } while (0)
#ifndef REP_MASK
#define REP_MASK 0u
#endif
#define PHASE(k, ...) if (IN(k)) { __VA_ARGS__; if constexpr ((((REP_MASK) >> (k)) & 1u) != 0u) { if (multi) xcd_barrier(bar, wv); __VA_ARGS__; } }
#define WSP(T, off) ((T*)(p.ws + (off)))
    constexpr int TAIL0 = CVT_EAGER, TAIL1 = TAIL0 + 2304, TAIL2 = TAIL1 + 768, TAIL3 = TAIL2 + 384, TAIL4 = TAIL3 + 840;
    static_assert(TAIL4 == CVT_ALL, "tail ranges");
    const int G = gridDim.x, c = blockIdx.x;

    PHASE(0, phase_prep(p, lds, wv);)
    SEAM(0);
    PHASE(1, phase_modreduce(p, wv);)
    SEAM(1);
    PHASE(2, phase_norm1_l0(p, wv);)
    SEAM(2);
    PHASE(3, { gm::Sched S; S.init(MT, IN0W / 256, G, c, 0, 0); gm::EpiInProj E{WSP(bf16_t, WS_R3 + R3_PROJ), WSP(bf16_t, WS_R3 + R3_UG), WSP(unsigned char, WS_VT8G)};
        gm::gemm_phase<gm::EpiInProj, false, true>(lds, WSP(bf16_t, WS_H), D / 2, 0, WSP(bf16_t, WS_W) + W_IN0, D / 2, 0, S, E, nullptr, 0, wv); })
    SEAM(3);
    PHASE(4, phase_kprep(p, wv);)
    SEAM(4);
    PHASE(5, phase_attn0_conv(p, lds, wv);)
    SEAM(5);
    PHASE(6, { gm::Sched S; S.init(MT, D / 256, G, c, 0, 0); gm::EpiResid E{p.in[0], p.in[2], nullptr, WSP(bf16_t, WS_XRES), mod_ptr(p, 0) + 2 * D};
        gm::gemm_phase<gm::EpiResid, false>(lds, WSP(bf16_t, WS_CAT), D, 0, WSP(bf16_t, WS_W) + W_OUT0, D, 0, S, E, nullptr, 0, wv);
        cvt_tail(p, TAIL0, TAIL1, 64, lds, wv); })
    SEAM(6);
    PHASE(7, phase_n2router(p, 0, lds, wv);)
    SEAM(7);
    PHASE(8, phase_topk(p, 0, lds, wv);)
    SEAM(8);
    PHASE(9, { gm::Sched S; S.init(NE * 9, 8, G, c, 2, 9); gm::EpiSwiglu E{WSP(unsigned char, WS_CAT), 2304};
        gm::gemm_phase<gm::EpiSwiglu, true, true>(lds, WSP(bf16_t, WS_H), D / 2, 0, WSP(bf16_t, WS_W) + W_GU0, D / 2, (size_t)2048 * D / 2, S, E, WSP(const int, WS_ROWIDX), 2304, wv);
        cvt_tail(p, TAIL1, TAIL2, 128, lds, wv); })
    SEAM(9);
    PHASE(10, { gm::Sched S; S.init(NE * 9, 8, G, c, 2, 9); gm::EpiDown E{WSP(unsigned char, WS_Y), WSP(const float, WS_GATE), 2304};
        gm::gemm_phase<gm::EpiDown, false, true>(lds, WSP(bf16_t, WS_CAT), DF / 2, (size_t)2304 * DF / 2, WSP(bf16_t, WS_W) + W_DN0, DF / 2, (size_t)D * DF / 2, S, E, nullptr, 0, wv);
        cvt_tail(p, TAIL2, TAIL3, 128, lds, wv); })
    SEAM(10);
    PHASE(11, phase_combine(p, 0, wv);)
    SEAM(11);
    PHASE(12, { gm::Sched S; S.init(MT, ZW / 256, G, c, 0, 0); gm::EpiStoreF8 E{WSP(unsigned char, WS_R3 + R3_Z), ZW};
        gm::gemm_phase<gm::EpiStoreF8, false, true>(lds, WSP(bf16_t, WS_H), D / 2, 0, WSP(bf16_t, WS_W) + W_DQKV, D / 2, 0, S, E, nullptr, 0, wv);
        cvt_tail(p, TAIL3, TAIL4, 136, lds, wv); })
    SEAM(12);
    PHASE(13, phase_l1prep(p, wv);)
    SEAM(13);
    PHASE(14, {
        { gm::Sched S; S.init(64, QW / 256, G, c, 1, 0); gm::EpiStoreBf16 E{WSP(bf16_t, WS_R3 + R3_Q1), QW, WSP(const float, WS_RSTDQ), 1};
          gm::gemm_phase<gm::EpiStoreBf16, false, true>(lds, WSP(bf16_t, WS_R3 + R3_Z), ZW / 2, 0, WSP(bf16_t, WS_W) + W_UQ, QLORA / 2, 0, S, E, nullptr, 0, wv); }
        { gm::Sched S; S.init(MT, KVW / 256, G, c, 0, 0); gm::EpiKV E{WSP(unsigned char, WS_VT8N), WSP(unsigned char, WS_K8N), WSP(const float, WS_RSTDKV)};
          gm::gemm_phase<gm::EpiKV, false, true>(lds, (const bf16_t*)(WSP(unsigned char, WS_R3 + R3_Z) + QLORA), ZW / 2, 0, WSP(bf16_t, WS_W) + W_UKV, KVLORA / 2, 0, S, E, nullptr, 0, wv); }
    })
    SEAM(14);
    PHASE(15, phase_attn1(p, lds, wv);)
    SEAM(15);
    PHASE(16, { gm::Sched S; S.init(64, D / 256, G, c, 1, 0); gm::EpiResid E{nullptr, nullptr, WSP(const bf16_t, WS_XRES), WSP(bf16_t, WS_XRES), mod_ptr(p, 1) + 2 * D};
        gm::gemm_phase<gm::EpiResid, false, true>(lds, WSP(bf16_t, WS_CAT), D / 2, 0, WSP(bf16_t, WS_W) + W_OUT1, D / 2, 0, S, E, nullptr, 0, wv, 0x7B7B7B7B); })
    SEAM(16);
    PHASE(17, phase_n2router(p, 1, lds, wv);)
    SEAM(17);
    PHASE(18, phase_topk(p, 1, lds, wv);)
    SEAM(18);
    PHASE(19, { gm::Sched S; S.init(NE * 8, 8, G, c, 2, 8); gm::EpiSwiglu E{WSP(unsigned char, WS_CAT), 2048};
        gm::gemm_phase<gm::EpiSwiglu, true, true>(lds, WSP(bf16_t, WS_H), D / 2, 0, WSP(bf16_t, WS_W) + W_GU1, D / 2, (size_t)2048 * D / 2, S, E, WSP(const int, WS_ROWIDX), 2048, wv); })
    SEAM(19);
    PHASE(20, { gm::Sched S; S.init(NE * 8, 8, G, c, 2, 8); gm::EpiDown E{WSP(unsigned char, WS_Y), WSP(const float, WS_GATE), 2048};
        gm::gemm_phase<gm::EpiDown, false, true>(lds, WSP(bf16_t, WS_CAT), DF / 2, (size_t)2048 * DF / 2, WSP(bf16_t, WS_W) + W_DN1, DF / 2, (size_t)D * DF / 2, S, E, nullptr, 0, wv); })
    SEAM(20);
    PHASE(21, phase_combine(p, 1, wv);)
#undef IN
#undef SEAM
#undef PHASE
#undef WSP
}

extern "C" void kernel_launch(void* const* d_in, const int* in_sizes, int n_in, void* d_out, int out_size, void* d_ws, size_t ws_size, hipStream_t stream) {
    static int grid = 0;
    if (grid == 0) {
        if (n_in != 35 || in_sizes[0] != NB * SEQ * D || out_size != NB * SEQ * D || ws_size < WS_END) {
            fprintf(stderr, "kernel_launch: shape/workspace mismatch: n_in %d in0 %d out %d ws %zu (need %zu); nothing launched\n", n_in, n_in > 0 ? in_sizes[0] : -1, out_size, ws_size, (size_t)WS_END); grid = -1; return; }
        int dev = 0, cus = 0, per_cu = 0;
        if (hipGetDevice(&dev) != hipSuccess || hipDeviceGetAttribute(&cus, hipDeviceAttributeMultiprocessorCount, dev) != hipSuccess) { fprintf(stderr, "kernel_launch: device query failed\n"); grid = -1; return; }
        if (hipFuncSetAttribute((const void*)mega, hipFuncAttributeMaxDynamicSharedMemorySize, LDS_BYTES) != hipSuccess) { fprintf(stderr, "kernel_launch: hipFuncSetAttribute failed\n"); grid = -1; return; }
        if (hipOccupancyMaxActiveBlocksPerMultiprocessor(&per_cu, (const void*)mega, NTHR, LDS_BYTES) != hipSuccess || per_cu < 1) fprintf(stderr, "kernel_launch: note: occupancy query says %d\n", per_cu);
        (void)hipGetLastError();
        grid = cus;
    }
    if (grid < 0) return;
    if (hipMemsetAsync((char*)d_ws + WS_CTL, 0, CTL_BYTES, stream) != hipSuccess) { fprintf(stderr, "kernel_launch: memset failed\n"); return; }
    Params p{};
    for (int i = 0; i < 35; ++i) p.in[i] = (const float*)d_in[i];
    p.out = (float*)d_out; p.ws = (unsigned char*)d_ws;
#if MK_MULTI
    for (int ph = 0; ph < NPH; ++ph) { p.ph_lo = ph; p.ph_hi = ph + 1; hipLaunchKernelGGL(mega, dim3(grid), dim3(NTHR), LDS_BYTES, stream, p); }
#else
    p.ph_lo = 0; p.ph_hi = NPH; hipLaunchKernelGGL(mega, dim3(grid), dim3(NTHR), LDS_BYTES, stream, p);
#endif
    const hipError_t le = hipPeekAtLastError();
    if (le != hipSuccess) fprintf(stderr, "kernel_launch: launch failed: %s\n", hipGetErrorName(le));
}
```

```cpp
#include <hip/hip_runtime.h>
#include <cstdio>
#include <cstdint>

#ifndef MK_MULTI
#define MK_MULTI 0
#endif

#define LAS __attribute__((address_space(3)))
typedef unsigned short bf16_t;
typedef short bf16x8 __attribute__((ext_vector_type(8)));
typedef short s16x4 __attribute__((ext_vector_type(4)));
typedef float f32x4 __attribute__((ext_vector_type(4)));
typedef float f32x2 __attribute__((ext_vector_type(2)));
typedef float f32x16 __attribute__((ext_vector_type(16)));
typedef unsigned u32x4 __attribute__((ext_vector_type(4)));
typedef unsigned u32x2 __attribute__((ext_vector_type(2)));
typedef int v8i __attribute__((ext_vector_type(8)));
typedef int v4i __attribute__((ext_vector_type(4)));

constexpr int D = 2048, NB = 8, SEQ = 2048, CL = 256, RPB = SEQ + CL, M = NB * RPB, MT = M / 256;
constexpr int NE = 16, DF = 1024;
constexpr int IN0W = 3584, QKVW = 1536, ZW = 2304, QLORA = 1536, KVLORA = 512, QW = 3072, KVW = 4096;
constexpr int NTHR = 512;
constexpr int LDS_BYTES = 147456, IDX_OFF = 131072, MISC_OFF = 131072 + 8192;
constexpr float EPS = 1e-6f;
constexpr int NPH = 22;

constexpr size_t al256(size_t x) { return (x + 255) / 256 * 256; }
constexpr size_t WS_CTL = 0, CTL_BYTES = 65536;
constexpr size_t WS_MODP = WS_CTL + CTL_BYTES;
constexpr size_t WS_MOD = WS_MODP + al256((size_t)2 * 32 * 9 * 12288 * 4);
constexpr size_t WS_ROPE = WS_MOD + al256((size_t)2 * 9 * 12288 * 4);
constexpr size_t WS_AFF = WS_ROPE + al256((size_t)2048 * 192 * 4);
constexpr size_t WS_TOKSLOT = WS_AFF + al256((size_t)M * 16 * 4);
constexpr size_t WS_ROWIDX = WS_TOKSLOT + al256((size_t)M * 16 * 4);
constexpr size_t WS_GATE = WS_ROWIDX + al256((size_t)16 * 2304 * 4);
constexpr size_t WS_RSTDQ = WS_GATE + al256((size_t)16 * 2304 * 4);
constexpr size_t WS_RSTDKV = WS_RSTDQ + al256((size_t)M * 4);
constexpr size_t WS_KPE = WS_RSTDKV + al256((size_t)M * 4);
constexpr size_t WS_K8G = WS_KPE + al256((size_t)M * 64 * 2);
constexpr size_t WS_K8N = WS_K8G + al256((size_t)M * 256);
constexpr size_t WS_VT8G = WS_K8N + al256((size_t)M * 2048);
constexpr size_t WS_VT8N = WS_VT8G + al256((size_t)NB * 2 * 128 * RPB);
constexpr size_t WS_XRES = WS_VT8N + al256((size_t)NB * 16 * 128 * RPB);
constexpr size_t WS_H = WS_XRES + al256((size_t)M * D * 4);
constexpr size_t WS_R3 = WS_H + al256((size_t)M * D * 2);
constexpr size_t R3_PROJ = 0, R3_UG = (size_t)M * IN0W * 2, R3_Z = 0, R3_Q1 = (size_t)M * ZW * 2;
constexpr size_t R3_BYTES = ((size_t)M * ZW * 2 + (size_t)NB * SEQ * QW * 2) > ((size_t)M * IN0W * 2 + (size_t)M * 1024 * 2) ? ((size_t)M * ZW * 2 + (size_t)NB * SEQ * QW * 2) : ((size_t)M * IN0W * 2 + (size_t)M * 1024 * 2);
constexpr size_t WS_CAT = WS_R3 + al256(R3_BYTES);
constexpr size_t WS_Y = WS_CAT + al256((size_t)M * D * 2);
constexpr size_t WS_W = WS_Y + al256((size_t)M * KVW * 2);
constexpr size_t W_IN0 = 0;
constexpr size_t W_OUT0 = W_IN0 + (size_t)IN0W * D;
constexpr size_t W_GU0 = W_OUT0 + (size_t)D * D;
constexpr size_t W_DN0 = W_GU0 + (size_t)NE * 2048 * D;
constexpr size_t W_DQKV = W_DN0 + (size_t)NE * D * DF;
constexpr size_t W_UQ = W_DQKV + (size_t)ZW * D;
constexpr size_t W_UKV = W_UQ + (size_t)QW * QLORA;
constexpr size_t W_OUT1 = W_UKV + (size_t)KVW * KVLORA;
constexpr size_t W_GU1 = W_OUT1 + (size_t)D * D;
constexpr size_t W_DN1 = W_GU1 + (size_t)NE * 2048 * D;
constexpr size_t W_END = W_DN1 + (size_t)NE * D * DF;
constexpr size_t WS_END = WS_W + W_END * 2;

struct Params { const float* in[35]; float* out; unsigned char* ws; int ph_lo, ph_hi; };

__device__ __forceinline__ f32x4 bf4_to_f32(u32x2 w) { return (f32x4){__uint_as_float(w.x << 16), __uint_as_float(w.x & 0xffff0000u), __uint_as_float(w.y << 16), __uint_as_float(w.y & 0xffff0000u)}; }
__device__ __forceinline__ unsigned cvt4_fp8_pl(float a, float b, float c, float d) { unsigned w; asm("v_cvt_pk_fp8_f32 %0, %1, %2\n\tv_cvt_pk_fp8_f32 %0, %3, %4 op_sel:[0,0,1]\n\ts_nop 1" : "=&v"(w) : "v"(a), "v"(b), "v"(c), "v"(d)); return w; }
__device__ __forceinline__ unsigned cvt_pk_bf16(float lo, float hi) { unsigned r; asm("v_cvt_pk_bf16_f32 %0, %1, %2" : "=v"(r) : "v"(lo), "v"(hi)); return r; }
__device__ __forceinline__ unsigned cvt4_fp8(float a, float b, float c, float d) { unsigned w; asm("v_cvt_pk_fp8_f32 %0, %1, %2\n\tv_cvt_pk_fp8_f32 %0, %3, %4 op_sel:[0,0,1]" : "=&v"(w) : "v"(a), "v"(b), "v"(c), "v"(d)); return w; }
__device__ __forceinline__ float bf_lo(unsigned w) { return __uint_as_float(w << 16); }
__device__ __forceinline__ float bf_hi(unsigned w) { return __uint_as_float(w & 0xffff0000u); }
__device__ __forceinline__ float bf2f(bf16_t h) { return __uint_as_float(((unsigned)h) << 16); }
__device__ __forceinline__ float wave_sum(float v) {
#pragma unroll
    for (int o = 32; o; o >>= 1) v += __shfl_xor(v, o);
    return v;
}
__device__ __forceinline__ int lane_id() { int r; asm volatile("v_mbcnt_lo_u32_b32 %0, -1, 0\n\tv_mbcnt_hi_u32_b32 %0, -1, %0" : "=v"(r)); return r; }
#define TID_OF(wv) ((wv) * 64 + lane_id())
__device__ __forceinline__ int key_slot(int k) { const int g = k & 31; return (k & ~31) | (((g & 3) + 4 * (g >> 3)) + 16 * ((g >> 2) & 1)); }
__device__ __forceinline__ float silu_f(float x) { return x * __builtin_amdgcn_rcpf(1.f + __builtin_amdgcn_exp2f(-1.4426950408889634f * x)); }
__device__ __forceinline__ float sigmoid_f(float x) { return __builtin_amdgcn_rcpf(1.f + __builtin_amdgcn_exp2f(-1.4426950408889634f * x)); }

#define XB_TMO      128
#define XB_XCNT(j)  (256  + 64 * (j))
#define XB_XSUB(j)  (1280 + 64 * (j))
#define XB_XGEN(j)  (2304 + 64 * (j))
#define XB_TOP      3328
#define XB_TOPGEN   3392
#define XCD_BAR_WORDS 3456
#define XB_SPIN_CAP (1u << 18)

__device__ __forceinline__ unsigned xb_ld(unsigned* p)              { return __hip_atomic_load(p, __ATOMIC_RELAXED, __HIP_MEMORY_SCOPE_AGENT); }
__device__ __forceinline__ unsigned xb_add(unsigned* p, unsigned v) { return __hip_atomic_fetch_add(p, v, __ATOMIC_RELAXED, __HIP_MEMORY_SCOPE_AGENT); }
__device__ __forceinline__ unsigned xb_xcc_id() { return (unsigned)__builtin_amdgcn_s_getreg((3 << 11) | 20) & 0xFu; }
#define XB_SPIN(cond, bar) do { unsigned _sp = 0; while (cond) { __builtin_amdgcn_s_sleep(1); \
    if ((++_sp & 255u) == 0u) { if (xb_ld(&(bar)[XB_TMO])) break; if (_sp > XB_SPIN_CAP) { atomicAdd(&(bar)[XB_TMO], 1u); break; } } } } while (0)

struct XcdBarrier { unsigned* bar; unsigned x; volatile LAS unsigned* st; };

__device__ __forceinline__ XcdBarrier xcd_barrier_post(unsigned* bar, volatile LAS unsigned* st, int wv) {
    XcdBarrier b; b.bar = bar; b.x = xb_xcc_id(); b.st = st;
    if (wv == 0 && lane_id() == 0) (void)xb_add(&bar[XB_XCNT(b.x)], 1u);
    return b;
}
__device__ __forceinline__ void xcd_barrier_complete(unsigned* bar, unsigned x, unsigned& nloc, unsigned& nx) {
    const unsigned G = gridDim.x * gridDim.y * gridDim.z;
    unsigned sum, cnt, mine, sp = 0u;
    for (;;) {
        sum = 0u; cnt = 0u; mine = 0u;
#pragma unroll
        for (unsigned j = 0; j < 16; ++j) { const unsigned c = xb_ld(&bar[XB_XCNT(j)]); sum += c; cnt += (c > 0u) ? 1u : 0u; mine = (j == x) ? c : mine; }
        if (sum == G) break;
        __builtin_amdgcn_s_sleep(1);
        if ((++sp & 255u) == 0u) { if (xb_ld(&bar[XB_TMO])) break; if (sp > XB_SPIN_CAP) { atomicAdd(&bar[XB_TMO], 1u); break; } }
    }
    nloc = mine > 0u ? mine : 1u; nx = cnt > 0u ? cnt : 1u;
}
__device__ __forceinline__ void xcd_barrier(const XcdBarrier& b, int wv) {
    asm volatile("s_waitcnt vmcnt(0)" ::: "memory");
    __syncthreads();
    if (wv == 0 && lane_id() == 0) {
        unsigned* bar = b.bar;
        __builtin_amdgcn_s_waitcnt(0);
        unsigned nloc = b.st[0], nx = b.st[1];
        if (nloc == 0u) { xcd_barrier_complete(bar, b.x, nloc, nx); b.st[0] = nloc; b.st[1] = nx; }
        const unsigned old = xb_add(&bar[XB_XSUB(b.x)], 1u);
        const unsigned gen = old / nloc;
        if (old + 1u == (gen + 1u) * nloc) {
            __builtin_amdgcn_fence(__ATOMIC_RELEASE, "agent");
            asm volatile("s_waitcnt vmcnt(0)" ::: "memory");
            const unsigned og = xb_add(&bar[XB_TOP], 1u);
            const unsigned tg = og / nx;
            if (og + 1u == (tg + 1u) * nx) xb_add(&bar[XB_TOPGEN], 1u);
            else XB_SPIN(xb_ld(&bar[XB_TOPGEN]) == tg, bar);
            __builtin_amdgcn_fence(__ATOMIC_ACQUIRE, "agent");
            xb_add(&bar[XB_XGEN(b.x)], 1u);
            asm volatile("s_waitcnt vmcnt(0)" ::: "memory");
        } else {
            XB_SPIN(xb_ld(&bar[XB_XGEN(b.x)]) == gen, bar);
            __builtin_amdgcn_fence(__ATOMIC_ACQUIRE, "agent");
            asm volatile("s_waitcnt vmcnt(0)" ::: "memory");
        }
    }
    __syncthreads();
}

namespace gm {
constexpr int BM = 256, BK = 64, HALF = 128, HTB = HALF * BK * 2, STAGE_BYTES = 8 * HTB, NXCD = 8, WGM = 6;
__host__ __device__ __forceinline__ int lds_byte(int r, int c) { const int st = (r >> 4) * 2 + (c >> 5), rr = r & 15, cc = c & 31, ob = rr * 64 + cc * 2; return st * 1024 + (ob ^ (((ob >> 9) & 1) << 5)); }
__host__ __device__ __forceinline__ void stage_rc(int b, int& R, int& C) { const int st = b / 1024, sb = b % 1024, swz = sb ^ (((sb >> 9) & 1) << 5); R = (st >> 1) * 16 + swz / 64; C = (st & 1) * 32 + (swz % 64) / 2; }
__host__ __device__ __forceinline__ int perm32(int rho) { const int n = rho >> 4, i = rho & 15; return 8 * (i >> 2) + 4 * n + (i & 3); }

struct Unit { int pm, pn, g; };

struct Sched {
    int nMv, nN, nwg, G, c, mode, tpg;
    __device__ void init(int nMv_, int nN_, int G_, int c_, int mode_, int tpg_) { nMv = nMv_; nN = nN_; nwg = nMv_ * nN_; G = G_; c = c_; mode = mode_; tpg = tpg_; }
    __device__ bool next(int i, Unit& u) const {
        const long L = (long)i * G + c; if (L >= nwg) return false;
        int wgid = (int)L; { const int q = nwg / NXCD, r = nwg % NXCD, xcd = wgid % NXCD, off = wgid / NXCD; wgid = (xcd < r ? xcd * (q + 1) : r * (q + 1) + (xcd - r) * q) + off; }
        const int nig = WGM * nN, gid = wgid / nig, fm = gid * WGM, gsz = (nMv - fm) < WGM ? (nMv - fm) : WGM;
        const int v = fm + ((wgid % nig) % gsz); u.pn = (wgid % nig) / gsz;
        if (mode == 0) { u.pm = v; u.g = 0; }
        else if (mode == 1) { u.pm = (v >> 3) * 9 + 1 + (v & 7); u.g = 0; }
        else { u.g = v / tpg; u.pm = v - u.g * tpg; }
        return true;
    }
};

struct EpiStoreBf16 {
    static constexpr bool PERM = true, SWAPV = false;
    bf16_t* O; int ldo; const float* rs; int rowmode;
    __device__ __forceinline__ void operator()(const f32x4 (&acc)[2][2][4][2], const Unit& u, int wr, int wc, int fr, int fq) const {
        const int urow0 = u.pm * 256 + wr * 64 + fr;
        int orow0 = urow0;
        if (rowmode == 1) { const int b = u.pm / 9, o = u.pm - b * 9; orow0 = b * 2048 + (o - 1) * 256 + wr * 64 + fr; }
        const int col0 = u.pn * 256 + wc * 32 + 8 * fq;
        float scv[8];
#pragma unroll
        for (int k = 0; k < 8; ++k) scv[k] = rs ? rs[urow0 + (k >> 2) * 128 + (k & 3) * 16] : 1.f;
#pragma unroll
        for (int ai = 0; ai < 2; ++ai)
#pragma unroll
            for (int m = 0; m < 4; ++m) {
                const int rr = ai * 128 + m * 16; const float sc = scv[ai * 4 + m]; bf16_t* rowp = O + (size_t)(orow0 + rr) * ldo + col0;
#pragma unroll
                for (int bj = 0; bj < 2; ++bj) { const f32x4 v0 = acc[ai][bj][m][0] * sc, v1 = acc[ai][bj][m][1] * sc;
                    u32x4 w; w.x = cvt_pk_bf16(v0[0], v0[1]); w.y = cvt_pk_bf16(v0[2], v0[3]); w.z = cvt_pk_bf16(v1[0], v1[1]); w.w = cvt_pk_bf16(v1[2], v1[3]);
                    *(u32x4*)(rowp + bj * 128) = w; }
            }
    }
};
struct EpiKV {
    static constexpr bool PERM = true, SWAPV = true;
    unsigned char* vt8; unsigned char* k8; const float* rs;
    __device__ __forceinline__ void operator()(const f32x4 (&acc)[2][2][4][2], const Unit& u, int wr, int wc, int fr, int fq) const {
        const int row0 = u.pm * 256 + wr * 64 + fr, c0 = wc * 32 + 8 * fq, b = u.pm / 9, kb = (u.pm - b * 9) * 256;
        float scv[8]; f32x4 sc4a[2][4];
#pragma unroll
        for (int k = 0; k < 8; ++k) scv[k] = rs[row0 + (k >> 2) * 128 + (k & 3) * 16];
#pragma unroll
        for (int ai = 0; ai < 2; ++ai)
#pragma unroll
            for (int m = 0; m < 4; ++m) sc4a[ai][m] = *(const f32x4*)(rs + u.pm * 256 + ai * 128 + wr * 64 + 4 * fq + 16 * m);
#pragma unroll
        for (int ai = 0; ai < 2; ++ai)
#pragma unroll
            for (int m = 0; m < 4; ++m) {
                const int row = row0 + ai * 128 + m * 16; const float sc = scv[ai * 4 + m];
                const f32x4 v0 = acc[ai][0][m][0] * sc, v1 = acc[ai][0][m][1] * sc; u32x2 w; w.x = cvt4_fp8(v0[0], v0[1], v0[2], v0[3]); w.y = cvt4_fp8(v1[0], v1[1], v1[2], v1[3]);
                *(u32x2*)(k8 + (size_t)row * 2048 + u.pn * 128 + c0) = w;
            }
#pragma unroll
        for (int ai = 0; ai < 2; ++ai) {
#pragma unroll
            for (int n = 0; n < 2; ++n) {
                unsigned W[4];
#pragma unroll
                for (int m = 0; m < 4; ++m) { const f32x4 v = acc[ai][1][m][n] * sc4a[ai][m]; W[m] = cvt4_fp8_pl(v[0], v[1], v[2], v[3]); }
                const auto p0 = __builtin_amdgcn_permlane32_swap(W[0], W[1], false, false), p1 = __builtin_amdgcn_permlane32_swap(W[2], W[3], false, false);
                const auto q0 = __builtin_amdgcn_permlane32_swap(p0[0], p1[0], false, false), q1 = __builtin_amdgcn_permlane32_swap(p0[1], p1[1], false, false);
                const u32x4 w = {q0[0], q1[0], q0[1], q1[1]};
                const int ch = wc * 32 + 8 * (fr >> 2) + 4 * n + (fr & 3);
                *(u32x4*)(vt8 + ((size_t)(b * 16 + u.pn) * 128 + ch) * RPB + kb + ai * 128 + wr * 64 + 16 * (fq & 1) + 32 * (fq >> 1)) = w;
            }
        }
    }
};
struct EpiStoreF8 {
    static constexpr bool PERM = true, SWAPV = false;
    unsigned char* O; int ldo;
    __device__ __forceinline__ void operator()(const f32x4 (&acc)[2][2][4][2], const Unit& u, int wr, int wc, int fr, int fq) const {
        const int row0 = u.pm * 256 + wr * 64 + fr, col0 = u.pn * 256 + wc * 32 + 8 * fq;
#pragma unroll
        for (int ai = 0; ai < 2; ++ai)
#pragma unroll
            for (int m = 0; m < 4; ++m) {
                unsigned char* rowp = O + (size_t)(row0 + ai * 128 + m * 16) * ldo + col0;
#pragma unroll
                for (int bj = 0; bj < 2; ++bj) { const f32x4 v0 = acc[ai][bj][m][0], v1 = acc[ai][bj][m][1];
                    u32x2 w; w.x = cvt4_fp8(v0[0], v0[1], v0[2], v0[3]); w.y = cvt4_fp8(v1[0], v1[1], v1[2], v1[3]); *(u32x2*)(rowp + bj * 128) = w; }
            }
    }
};
struct EpiInProj {
    static constexpr bool PERM = true, SWAPV = false;
    bf16_t* qkv; bf16_t* ug; unsigned char* vt8;
    __device__ __forceinline__ void operator()(const f32x4 (&acc)[2][2][4][2], const Unit& u, int wr, int wc, int fr, int fq) const {
        const int row0 = u.pm * 256 + wr * 64 + fr;
        if (u.pn < 6) {
            const int col0 = u.pn * 256 + wc * 32 + 8 * fq;
#pragma unroll
            for (int ai = 0; ai < 2; ++ai)
#pragma unroll
                for (int m = 0; m < 4; ++m) { bf16_t* rowp = qkv + (size_t)(row0 + ai * 128 + m * 16) * QKVW + col0;
#pragma unroll
                    for (int bj = 0; bj < 2; ++bj) { const f32x4 v0 = acc[ai][bj][m][0], v1 = acc[ai][bj][m][1];
                        u32x4 w; w.x = cvt_pk_bf16(v0[0], v0[1]); w.y = cvt_pk_bf16(v0[2], v0[3]); w.z = cvt_pk_bf16(v1[0], v1[1]); w.w = cvt_pk_bf16(v1[2], v1[3]);
                        *(u32x4*)(rowp + bj * 128) = w; } }
            if (u.pn == 5) {
                const int b = u.pm / 9, key0 = (u.pm - b * 9) * 256 + wr * 64 + fr;
#pragma unroll
                for (int ai = 0; ai < 2; ++ai)
#pragma unroll
                    for (int m = 0; m < 4; ++m) { const int ks = key_slot(key0 + ai * 128 + m * 16);
#pragma unroll
                        for (int bj = 0; bj < 2; ++bj) { unsigned char* vp = vt8 + ((size_t)(b * 2 + bj) * 128 + wc * 32 + 8 * fq) * RPB + ks;
#pragma unroll
                            for (int n = 0; n < 2; ++n) { const unsigned w = cvt4_fp8(acc[ai][bj][m][n][0], acc[ai][bj][m][n][1], acc[ai][bj][m][n][2], acc[ai][bj][m][n][3]);
#pragma unroll
                                for (int j = 0; j < 4; ++j) vp[(size_t)(4 * n + j) * RPB] = (unsigned char)((w >> (8 * j)) & 0xffu); } } }
            }
        } else {
            const int col0 = (u.pn - 6) * 128 + wc * 32 + 8 * fq;
#pragma unroll
            for (int ai = 0; ai < 2; ++ai)
#pragma unroll
                for (int m = 0; m < 4; ++m) { bf16_t* rowp = ug + (size_t)(row0 + ai * 128 + m * 16) * 1024 + col0;
                    float h[8];
#pragma unroll
                    for (int n = 0; n < 2; ++n)
#pragma unroll
                        for (int j = 0; j < 4; ++j) h[n * 4 + j] = acc[ai][0][m][n][j] * sigmoid_f(acc[ai][1][m][n][j]);
                    u32x4 w; w.x = cvt_pk_bf16(h[0], h[1]); w.y = cvt_pk_bf16(h[2], h[3]); w.z = cvt_pk_bf16(h[4], h[5]); w.w = cvt_pk_bf16(h[6], h[7]);
                    *(u32x4*)rowp = w; }
        }
    }
};
struct EpiResid {
    static constexpr bool PERM = true, SWAPV = false;
    const float* xin; const float* cin; const bf16_t* xsrc; bf16_t* xres; const float* ga;
    __device__ __forceinline__ void operator()(const f32x4 (&acc)[2][2][4][2], const Unit& u, int wr, int wc, int fr, int fq) const {
        const int b = u.pm / 9, o = u.pm - b * 9, bs = (o == 0) ? 8 : b;
        const float* srow0 = o == 0 ? cin + (size_t)(b * 256) * D : xin + (size_t)(b * 2048 + (o - 1) * 256) * D;
        const size_t prow0 = (size_t)(u.pm * 256) * D;
        const int col0 = u.pn * 256 + wc * 32 + 8 * fq;
        f32x4 gv[2][2];
#pragma unroll
        for (int bj = 0; bj < 2; ++bj)
#pragma unroll
            for (int n = 0; n < 2; ++n) gv[bj][n] = *(const f32x4*)(ga + (size_t)bs * 12288 + col0 + bj * 128 + n * 4);
#pragma unroll
        for (int ai = 0; ai < 2; ++ai)
#pragma unroll
            for (int m = 0; m < 4; ++m) {
                const size_t ro = (size_t)(wr * 64 + fr + ai * 128 + m * 16) * D + col0;
#pragma unroll
                for (int bj = 0; bj < 2; ++bj) { f32x4 s0, s1;
                    if (xsrc) { const u32x4 w = *(const u32x4*)(xsrc + prow0 + ro + bj * 128); s0 = bf4_to_f32((u32x2){w.x, w.y}); s1 = bf4_to_f32((u32x2){w.z, w.w}); }
                    else { s0 = *(const f32x4*)(srow0 + ro + bj * 128); s1 = *(const f32x4*)(srow0 + ro + bj * 128 + 4); }
                    const f32x4 v0 = s0 + gv[bj][0] * acc[ai][bj][m][0], v1 = s1 + gv[bj][1] * acc[ai][bj][m][1];
                    u32x4 w; w.x = cvt_pk_bf16(v0[0], v0[1]); w.y = cvt_pk_bf16(v0[2], v0[3]); w.z = cvt_pk_bf16(v1[0], v1[1]); w.w = cvt_pk_bf16(v1[2], v1[3]);
                    *(u32x4*)(xres + prow0 + ro + bj * 128) = w; }
            }
    }
};
struct EpiSwiglu {
    static constexpr bool PERM = true, SWAPV = false;
    unsigned char* hid; int rpg;
    __device__ __forceinline__ void operator()(const f32x4 (&acc)[2][2][4][2], const Unit& u, int wr, int wc, int fr, int fq) const {
        const int row0 = u.g * rpg + u.pm * 256 + wr * 64 + fr, col0 = u.pn * 128 + wc * 32 + 8 * fq;
#pragma unroll
        for (int ai = 0; ai < 2; ++ai)
#pragma unroll
            for (int m = 0; m < 4; ++m) {
                unsigned char* rowp = hid + (size_t)(row0 + ai * 128 + m * 16) * DF + col0;
                float h[8];
#pragma unroll
                for (int n = 0; n < 2; ++n)
#pragma unroll
                    for (int j = 0; j < 4; ++j) h[n * 4 + j] = silu_f(acc[ai][0][m][n][j]) * acc[ai][1][m][n][j];
                u32x2 w;
                w.x = cvt4_fp8(h[0], h[1], h[2], h[3]); w.y = cvt4_fp8(h[4], h[5], h[6], h[7]);
                *(u32x2*)rowp = w;
            }
    }
};
struct EpiDown {
    static constexpr bool PERM = true, SWAPV = false;
    unsigned char* y; const float* gate; int rpg;
    __device__ __forceinline__ void operator()(const f32x4 (&acc)[2][2][4][2], const Unit& u, int wr, int wc, int fr, int fq) const {
        const int row0 = u.g * rpg + u.pm * 256 + wr * 64 + fr, col0 = u.pn * 256 + wc * 32 + 8 * fq;
        float gv[8];
#pragma unroll
        for (int k = 0; k < 8; ++k) gv[k] = gate[row0 + (k >> 2) * 128 + (k & 3) * 16];
#pragma unroll
        for (int ai = 0; ai < 2; ++ai)
#pragma unroll
            for (int m = 0; m < 4; ++m) {
                const int r = row0 + ai * 128 + m * 16; const float sc = gv[ai * 4 + m] * 32.f; unsigned char* rowp = y + (size_t)r * D + col0;
#pragma unroll
                for (int bj = 0; bj < 2; ++bj) { const f32x4 v0 = acc[ai][bj][m][0] * sc, v1 = acc[ai][bj][m][1] * sc;
                    u32x2 w; w.x = cvt4_fp8(v0[0], v0[1], v0[2], v0[3]); w.y = cvt4_fp8(v1[0], v1[1], v1[2], v1[3]); *(u32x2*)(rowp + bj * 128) = w; }
            }
    }
};

template <class Epi, bool GATHER, bool F8 = false>
__device__ __forceinline__ void gemm_phase(LAS unsigned char* lds, const bf16_t* A, int lda, size_t a_gs, const bf16_t* Bt, int K, size_t b_gs,
                                           const Sched& S, const Epi& E, const int* rowidx, int rpg, int wv, int scl_a_ = 0x7F7F7F7F) {
    const int lane = lane_id(), tid = wv * 64 + lane, wid = wv, wr = wid >> 2, wc = wid & 3, fr = lane & 15, fq = lane >> 4;
    const int nt = K / BK;
    unsigned voffA[2], voffB[2]; int Rr[2], Cc[2];
#pragma unroll
    for (int i = 0; i < 2; ++i) { int R, C; stage_rc(tid * 16 + i * 8192, R, C); const int Rb = Epi::PERM ? ((R & ~31) + perm32(R & 31)) : R;
        voffA[i] = (unsigned)(R * lda + C) * 2u; voffB[i] = (unsigned)(Rb * K + C) * 2u; Rr[i] = R; Cc[i] = C; }
    const size_t kstep = (size_t)(BK * 2);
    const size_t hstepA = (size_t)HALF * lda * 2, hstepB = (size_t)HALF * K * 2;
    const size_t tstepA = 2 * hstepA, tstepB = 2 * hstepB;
    const unsigned ldsw = (unsigned)wid * 1024u;
    const int aoff = lds_byte(wr * 64 + fr, fq * 8), boff = lds_byte(wc * 32 + fr, fq * 8);
    LAS int* idx = (LAS int*)(lds + IDX_OFF);
    Unit cur, nxt; int ui = 0;
    if (!S.next(0, cur)) return;
    if constexpr (GATHER) {
        int iv[8]; bool ok[8]; Unit u = cur;
#pragma unroll
        for (int i = 0; i < 8; ++i) { Unit un; ok[i] = S.next(i, un); if (ok[i]) u = un; iv[i] = rowidx[u.g * rpg + u.pm * 256 + (tid & 255)]; }
#pragma unroll
        for (int i = 0; i < 8; ++i) if (ok[i] && tid < 256) idx[i * 256 + tid] = iv[i];
        __syncthreads();
    }
#define GM_SA(b, h) (((b) * 2 + (h)) * HTB)
#define GM_SB(b, h) ((4 + (b) * 2 + (h)) * HTB)
#define GM_LD2(bufoff, gbase, o0, o1) do { \
        __builtin_amdgcn_global_load_lds((const unsigned*)((const char*)(gbase) + (o0)), (LAS unsigned*)(lds + (bufoff) + ldsw), 16, 0, 0); \
        __builtin_amdgcn_global_load_lds((const unsigned*)((const char*)(gbase) + (o1)), (LAS unsigned*)(lds + (bufoff) + ldsw + 8192), 16, 0, 0); } while (0)
#define GM_STAGE_B(bufoff, gbase) GM_LD2(bufoff, gbase, voffB[0], voffB[1])
#define GM_STAGE_A(bufoff, kb, h, OFF) do { if constexpr (GATHER) GM_LD2(bufoff, kb, OFF[h][0], OFF[h][1]); else GM_LD2(bufoff, (kb) + (h) * hstepA, voffA[0], voffA[1]); } while (0)
#define GM_LDA(dst, b, h) do { if constexpr (F8) { _Pragma("unroll") for (int m = 0; m < 4; ++m) dst##8[m] = __builtin_shufflevector(*(const LAS v4i*)(lds + GM_SA(b, h) + aoff + m * 2048), *(const LAS v4i*)(lds + GM_SA(b, h) + aoff + m * 2048 + 1024), 0, 1, 2, 3, 4, 5, 6, 7); } \
        else { _Pragma("unroll") for (int m = 0; m < 4; ++m) _Pragma("unroll") for (int k = 0; k < 2; ++k) dst[m][k] = *(const LAS bf16x8*)(lds + GM_SA(b, h) + aoff + m * 2048 + k * 1024); } } while (0)
#define GM_LDB(dst, b, h) do { if constexpr (F8) { _Pragma("unroll") for (int n = 0; n < 2; ++n) dst##8[n] = __builtin_shufflevector(*(const LAS v4i*)(lds + GM_SB(b, h) + boff + n * 2048), *(const LAS v4i*)(lds + GM_SB(b, h) + boff + n * 2048 + 1024), 0, 1, 2, 3, 4, 5, 6, 7); } \
        else { _Pragma("unroll") for (int n = 0; n < 2; ++n) _Pragma("unroll") for (int k = 0; k < 2; ++k) dst[n][k] = *(const LAS bf16x8*)(lds + GM_SB(b, h) + boff + n * 2048 + k * 1024); } } while (0)
#define GM_MMA(ai, bj, At, Bt_) do { __builtin_amdgcn_s_setprio(1); \
        if constexpr (F8) { _Pragma("unroll") for (int m = 0; m < 4; ++m) _Pragma("unroll") for (int n = 0; n < 2; ++n) { \
            if constexpr (Epi::SWAPV && (bj) == 1) asm volatile("v_mfma_scale_f32_16x16x128_f8f6f4 %0, %1, %2, %0, %3, %4 op_sel_hi:[0,0,0]" : "+v"(acc[ai][bj][m][n]) : "v"(At##8[m]), "v"(Bt_##8[n]), "v"(scl_a), "v"(scl_w)); \
            else asm volatile("v_mfma_scale_f32_16x16x128_f8f6f4 %0, %1, %2, %0, %3, %4 op_sel_hi:[0,0,0]" : "+v"(acc[ai][bj][m][n]) : "v"(Bt_##8[n]), "v"(At##8[m]), "v"(scl_w), "v"(scl_a)); } } \
        else { _Pragma("unroll") for (int m = 0; m < 4; ++m) _Pragma("unroll") for (int n = 0; n < 2; ++n) _Pragma("unroll") for (int k = 0; k < 2; ++k) \
            acc[ai][bj][m][n] = __builtin_amdgcn_mfma_f32_16x16x32_bf16(Bt_[n][k], At[m][k], acc[ai][bj][m][n], 0, 0, 0); } \
        __builtin_amdgcn_s_setprio(0); } while (0)
#define GM_MMAZ(ai, bj, At, Bt_) do { __builtin_amdgcn_s_setprio(1); \
        if constexpr (F8) { _Pragma("unroll") for (int m = 0; m < 4; ++m) _Pragma("unroll") for (int n = 0; n < 2; ++n) { \
            if constexpr (Epi::SWAPV && (bj) == 1) asm volatile("v_mfma_scale_f32_16x16x128_f8f6f4 %0, %1, %2, 0, %3, %4 op_sel_hi:[0,0,0]" : "=&v"(acc[ai][bj][m][n]) : "v"(At##8[m]), "v"(Bt_##8[n]), "v"(scl_a), "v"(scl_w)); \
            else asm volatile("v_mfma_scale_f32_16x16x128_f8f6f4 %0, %1, %2, 0, %3, %4 op_sel_hi:[0,0,0]" : "=&v"(acc[ai][bj][m][n]) : "v"(Bt_##8[n]), "v"(At##8[m]), "v"(scl_w), "v"(scl_a)); } } \
        else { _Pragma("unroll") for (int m = 0; m < 4; ++m) _Pragma("unroll") for (int n = 0; n < 2; ++n) { \
            acc[ai][bj][m][n] = __builtin_amdgcn_mfma_f32_16x16x32_bf16(Bt_[n][0], At[m][0], (f32x4){0.f, 0.f, 0.f, 0.f}, 0, 0, 0); \
            acc[ai][bj][m][n] = __builtin_amdgcn_mfma_f32_16x16x32_bf16(Bt_[n][1], At[m][1], acc[ai][bj][m][n], 0, 0, 0); } } \
        __builtin_amdgcn_s_setprio(0); } while (0)
#define GM_WAIT_V(n) asm volatile("s_waitcnt vmcnt(" #n ")" ::: "memory")
#define GM_WAIT_L(n) asm volatile("s_waitcnt lgkmcnt(" #n ")" ::: "memory")
#define GM_BAR __builtin_amdgcn_s_barrier()
#define GM_SCHED __builtin_amdgcn_sched_barrier(0)
#define GM_OFFS(dst, uix) do { _Pragma("unroll") for (int h = 0; h < 2; ++h) _Pragma("unroll") for (int i = 0; i < 2; ++i) dst[h][i] = (unsigned)(idx[(uix) * 256 + h * 128 + Rr[i]] * lda + Cc[i]) * 2u; } while (0)
    f32x4 acc[2][2][4][2];
    if constexpr (!F8) {
#pragma unroll
    for (int a = 0; a < 2; ++a)
#pragma unroll
        for (int b = 0; b < 2; ++b)
#pragma unroll
            for (int m = 0; m < 4; ++m)
#pragma unroll
                for (int n = 0; n < 2; ++n) acc[a][b][m][n] = (f32x4){0.f, 0.f, 0.f, 0.f}; }
    bf16x8 At[4][2], B0[2][2], B1[2][2]; v8i At8[4], B08[2], B18[2];
    const int scl_w = 0x7A7A7A7A, scl_a = scl_a_;
    unsigned offc[2][2] = {{0u, 0u}, {0u, 0u}}, offn[2][2] = {{0u, 0u}, {0u, 0u}};
    if constexpr (GATHER) GM_OFFS(offc, 0);
    const char* Ab = (const char*)A; const char* Bb = (const char*)Bt;
    const char* cA = GATHER ? Ab : Ab + (size_t)cur.g * a_gs * 2 + (size_t)cur.pm * tstepA;
    const char* cB = Bb + (size_t)cur.g * b_gs * 2 + (size_t)cur.pn * tstepB;
    GM_STAGE_B(GM_SB(0, 0), cB); GM_STAGE_B(GM_SB(0, 1), cB + hstepB); GM_STAGE_A(GM_SA(0, 0), cA, 0, offc); GM_STAGE_A(GM_SA(0, 1), cA, 1, offc);
    if (wr == 1) GM_BAR;
    GM_WAIT_V(2); GM_BAR;
    GM_STAGE_B(GM_SB(1, 0), cB + kstep); GM_STAGE_A(GM_SA(1, 0), cA + kstep, 0, offc); GM_STAGE_B(GM_SB(1, 1), cB + hstepB + kstep);
    GM_WAIT_V(6); GM_BAR;
    for (;;) {
        const bool has_next = S.next(ui + 1, nxt);
        const char* nA = GATHER ? Ab : (has_next ? Ab + (size_t)nxt.g * a_gs * 2 + (size_t)nxt.pm * tstepA : cA);
        const char* nB = has_next ? Bb + (size_t)nxt.g * b_gs * 2 + (size_t)nxt.pn * tstepB : cB;
        if constexpr (GATHER) { if (has_next) GM_OFFS(offn, ui + 1); else {
#pragma unroll
            for (int h = 0; h < 2; ++h)
#pragma unroll
                for (int i = 0; i < 2; ++i) offn[h][i] = offc[h][i]; } }
#define GM_ITER(MM_) do { \
            const bool last = (t == nt - 2); \
            const char* a1 = cA + (size_t)(t + 1) * kstep; \
            const char* a2 = last ? nA : cA + (size_t)(t + 2) * kstep; const char* b2 = last ? nB : cB + (size_t)(t + 2) * kstep; \
            const char* a3 = a2 + kstep; const char* b3 = b2 + kstep; \
            unsigned o2[2][2]; \
_Pragma("unroll") \
            for (int h = 0; h < 2; ++h) \
_Pragma("unroll") \
                for (int i = 0; i < 2; ++i) o2[h][i] = last ? offn[h][i] : offc[h][i]; \
            GM_LDB(B0, 0, 0); GM_LDB(B1, 0, 1); GM_SCHED; GM_LDA(At, 0, 0); GM_STAGE_A(GM_SA(1, 1), a1, 1, offc); \
            GM_WAIT_V(8); GM_WAIT_L(0); GM_BAR; MM_(0, 0, At, B0); MM_(0, 1, At, B1); GM_BAR; GM_SCHED; \
            GM_LDA(At, 0, 1); GM_STAGE_B(GM_SB(0, 0), b2); GM_STAGE_B(GM_SB(0, 1), b2 + hstepB); GM_STAGE_A(GM_SA(0, 0), a2, 0, o2); \
            GM_WAIT_V(8); GM_WAIT_L(0); GM_BAR; MM_(1, 0, At, B0); MM_(1, 1, At, B1); GM_BAR; GM_SCHED; \
            GM_LDB(B0, 1, 0); GM_LDB(B1, 1, 1); GM_SCHED; GM_LDA(At, 1, 0); GM_STAGE_A(GM_SA(0, 1), a2, 1, o2); \
            GM_WAIT_V(8); GM_WAIT_L(0); GM_BAR; GM_MMA(0, 0, At, B0); GM_MMA(0, 1, At, B1); GM_BAR; GM_SCHED; \
            GM_LDA(At, 1, 1); GM_STAGE_B(GM_SB(1, 0), b3); GM_STAGE_B(GM_SB(1, 1), b3 + hstepB); GM_STAGE_A(GM_SA(1, 0), a3, 0, o2); \
            GM_WAIT_V(8); GM_WAIT_L(0); GM_BAR; GM_MMA(1, 0, At, B0); GM_MMA(1, 1, At, B1); GM_BAR; GM_SCHED; \
        } while (0)
        if constexpr (F8) {
            { const int t = 0; GM_ITER(GM_MMAZ); }
#pragma nounroll
            for (int t = 2; t < nt; t += 2) GM_ITER(GM_MMA);
        } else {
#pragma nounroll
            for (int t = 0; t < nt; t += 2) GM_ITER(GM_MMA);
        }
#undef GM_ITER
        if (wr == 0) GM_BAR;
        if constexpr (F8) asm volatile("s_nop 15\n\ts_nop 15" ::: "memory");
        E(acc, cur, wr, wc, fr, fq);
        if (!has_next) break;
        if constexpr (!F8) {
#pragma unroll
        for (int a = 0; a < 2; ++a)
#pragma unroll
            for (int b = 0; b < 2; ++b)
#pragma unroll
                for (int m = 0; m < 4; ++m)
#pragma unroll
                    for (int n = 0; n < 2; ++n) acc[a][b][m][n] = (f32x4){0.f, 0.f, 0.f, 0.f}; }
        cur = nxt; cA = nA; cB = nB; ++ui;
#pragma unroll
        for (int h = 0; h < 2; ++h)
#pragma unroll
            for (int i = 0; i < 2; ++i) offc[h][i] = offn[h][i];
        if (wr == 1) GM_BAR;
    }
    GM_WAIT_V(0);
    GM_BAR;
#undef GM_SA
#undef GM_SB
#undef GM_LD2
#undef GM_STAGE_B
#undef GM_STAGE_A
#undef GM_LDA
#undef GM_LDB
#undef GM_MMA
#undef GM_MMAZ
#undef GM_WAIT_V
#undef GM_WAIT_L
#undef GM_BAR
#undef GM_SCHED
#undef GM_OFFS
}
}

namespace at {
constexpr int NW = 8, QBLK = 32, KVBLK = 64;
constexpr float THR = 8.f;
#define AT_KSWZ(RB, row, colB) ((row) * (RB) + ((colB) ^ (((row) & 7) << 4)))
#define AT_SBAR() __builtin_amdgcn_sched_barrier(0)
__device__ __forceinline__ int crow(int r, int hi) { return (r & 3) + 8 * (r >> 2) + 4 * hi; }
__device__ __forceinline__ unsigned cvtpk(float lo, float hi) { unsigned r; asm volatile("v_cvt_pk_bf16_f32 %0, %1, %2" : "=v"(r) : "v"(lo), "v"(hi)); return r; }

template <int QM> struct Cst { static constexpr float SCALE = QM == 0 ? 0.088388347648318440f : 0.072168783648703220f; static constexpr float C = SCALE * 1.4426950408889634f; };

template <int QM, int THRI = 8>
__device__ __forceinline__ void partialSM(f32x16& p0, f32x16& p1, float& m_reg, float& mn, float& alpha) {
  constexpr float C = Cst<QM>::C, SC = Cst<QM>::SCALE, THR = (float)THRI;
  float pmax = p0[0];
#pragma unroll
  for (int r = 1; r < 16; ++r) pmax = fmaxf(pmax, p0[r]);
#pragma unroll
  for (int r = 0; r < 16; ++r) pmax = fmaxf(pmax, p1[r]);
  { auto rr = __builtin_amdgcn_permlane32_swap(__float_as_uint(pmax), __float_as_uint(pmax), false, false);
    pmax = fmaxf(__uint_as_float(rr[0]), __uint_as_float(rr[1])); }
  if (__builtin_expect(__all(pmax - m_reg <= THR / SC), 1)) { mn = m_reg; alpha = 1.f; }
  else { mn = fmaxf(m_reg, pmax); alpha = __builtin_amdgcn_exp2f((m_reg - mn) * C); m_reg = mn; }
  float mnC = -mn * C;
#pragma unroll
  for (int r = 0; r < 16; ++r) p0[r] = fmaf(p0[r], C, mnC);
#pragma unroll
  for (int r = 0; r < 16; ++r) p1[r] = fmaf(p1[r], C, mnC);
#pragma unroll
  for (int r = 0; r < 16; ++r) p0[r] = __builtin_amdgcn_exp2f(p0[r]);
}
__device__ __forceinline__ void finishSM(f32x16& p0, f32x16& p1, float alpha, float& l_reg, bf16x8& pa0, bf16x8& pa1, bf16x8& pa2, bf16x8& pa3) {
#pragma unroll
  for (int r = 0; r < 16; ++r) p1[r] = __builtin_amdgcn_exp2f(p1[r]);
  float ps = 0;
#pragma unroll
  for (int r = 0; r < 16; ++r) ps += p0[r];
#pragma unroll
  for (int r = 0; r < 16; ++r) ps += p1[r];
  { auto rr = __builtin_amdgcn_permlane32_swap(__float_as_uint(ps), __float_as_uint(ps), false, false);
    ps = __uint_as_float(rr[0]) + __uint_as_float(rr[1]); }
  l_reg = l_reg * alpha + ps;
#define AT_PK4(P, BASE, OUT) do { unsigned a0 = cvtpk(P[BASE + 0], P[BASE + 1]), a1 = cvtpk(P[BASE + 2], P[BASE + 3]);   \
    unsigned b0 = cvtpk(P[BASE + 4], P[BASE + 5]), b1 = cvtpk(P[BASE + 6], P[BASE + 7]);                              \
    auto r0 = __builtin_amdgcn_permlane32_swap(a0, b0, false, false); auto r1 = __builtin_amdgcn_permlane32_swap(a1, b1, false, false); \
    u32x4 w = {r0[0], r1[0], r0[1], r1[1]}; OUT = *reinterpret_cast<bf16x8*>(&w); } while (0)
  AT_PK4(p0, 0, pa0); AT_PK4(p0, 8, pa1); AT_PK4(p1, 0, pa2); AT_PK4(p1, 8, pa3);
#undef AT_PK4
}
template <int DQK>
__device__ __forceinline__ void qkt(f32x16& p0, f32x16& p1, const LAS char* kb, const bf16x8* qr) {
  constexpr int RBP = DQK * 2 + 16;
  p0 = f32x16{}; p1 = f32x16{};
#pragma unroll
  for (int d0 = 0; d0 < DQK / 16; ++d0) {
    bf16x8 b0 = *reinterpret_cast<const LAS bf16x8*>(kb + d0 * 32);
    bf16x8 b1 = *reinterpret_cast<const LAS bf16x8*>(kb + 32 * RBP + d0 * 32);
    p0 = __builtin_amdgcn_mfma_f32_32x32x16_bf16(b0, qr[d0], p0, 0, 0, 0);
    p1 = __builtin_amdgcn_mfma_f32_32x32x16_bf16(b1, qr[d0], p1, 0, 0, 0); }
}
__device__ __forceinline__ void finishSM8(f32x16& p0, f32x16& p1, float alpha, float& l_reg, v8i& p8) {
#pragma unroll
  for (int r = 0; r < 16; ++r) p1[r] = __builtin_amdgcn_exp2f(p1[r]);
  float ps = 0;
#pragma unroll
  for (int r = 0; r < 16; ++r) ps += p0[r];
#pragma unroll
  for (int r = 0; r < 16; ++r) ps += p1[r];
  { auto rr = __builtin_amdgcn_permlane32_swap(__float_as_uint(ps), __float_as_uint(ps), false, false);
    ps = __uint_as_float(rr[0]) + __uint_as_float(rr[1]); }
  l_reg = l_reg * alpha + ps;
#pragma unroll
  for (int q = 0; q < 4; ++q) { const unsigned g0 = cvt4_fp8(p0[4 * q], p0[4 * q + 1], p0[4 * q + 2], p0[4 * q + 3]), g1 = cvt4_fp8(p1[4 * q], p1[4 * q + 1], p1[4 * q + 2], p1[4 * q + 3]);
    auto rr = __builtin_amdgcn_permlane32_swap(g0, g1, false, false); p8[q] = (int)rr[0]; p8[4 + q] = (int)rr[1]; }
}
__device__ __forceinline__ void pv8(f32x16* o, const LAS char* vb, const v8i& p8, int scl) {
  constexpr int RPV = KVBLK + 16;
  v8i v[4];
#pragma unroll
  for (int d0 = 0; d0 < 4; ++d0) v[d0] = __builtin_shufflevector(*(const LAS v4i*)(vb + d0 * 32 * RPV), *(const LAS v4i*)(vb + d0 * 32 * RPV + 16), 0, 1, 2, 3, 4, 5, 6, 7);
  asm volatile("v_mfma_scale_f32_32x32x64_f8f6f4 %0, %1, %2, %0, %3, %3 op_sel_hi:[0,0,0]" : "+v"(o[0]) : "v"(p8), "v"(v[0]), "v"(scl));
  asm volatile("v_mfma_scale_f32_32x32x64_f8f6f4 %0, %1, %2, %0, %3, %3 op_sel_hi:[0,0,0]" : "+v"(o[1]) : "v"(p8), "v"(v[1]), "v"(scl));
  asm volatile("v_mfma_scale_f32_32x32x64_f8f6f4 %0, %1, %2, %0, %3, %3 op_sel_hi:[0,0,0]" : "+v"(o[2]) : "v"(p8), "v"(v[2]), "v"(scl));
  asm volatile("v_mfma_scale_f32_32x32x64_f8f6f4 %0, %1, %2, %0, %3, %3 op_sel_hi:[0,0,0]\n\ts_nop 15\n\ts_nop 15" : "+v"(o[3]) : "v"(p8), "v"(v[3]), "v"(scl));
}
template <int QM, int THRI>
__device__ __forceinline__ void pv8_psm(f32x16* o, const LAS char* vb, const v8i& p8, int scl, f32x16& p0, f32x16& p1, float& m_reg, float& mn, float& alpha) {
  constexpr int RPV = KVBLK + 16; constexpr float C = Cst<QM>::C, SC = Cst<QM>::SCALE, THR = (float)THRI;
  v8i v[4];
#pragma unroll
  for (int d0 = 0; d0 < 4; ++d0) v[d0] = __builtin_shufflevector(*(const LAS v4i*)(vb + d0 * 32 * RPV), *(const LAS v4i*)(vb + d0 * 32 * RPV + 16), 0, 1, 2, 3, 4, 5, 6, 7);
  asm volatile("v_mfma_scale_f32_32x32x64_f8f6f4 %0, %1, %2, %0, %3, %3 op_sel_hi:[0,0,0]" : "+v"(o[0]) : "v"(p8), "v"(v[0]), "v"(scl));
  float pmax = p0[0];
#pragma unroll
  for (int r = 1; r < 16; ++r) pmax = fmaxf(pmax, p0[r]);
  AT_SBAR();
  asm volatile("v_mfma_scale_f32_32x32x64_f8f6f4 %0, %1, %2, %0, %3, %3 op_sel_hi:[0,0,0]" : "+v"(o[1]) : "v"(p8), "v"(v[1]), "v"(scl));
#pragma unroll
  for (int r = 0; r < 16; ++r) pmax = fmaxf(pmax, p1[r]);
  { auto rr = __builtin_amdgcn_permlane32_swap(__float_as_uint(pmax), __float_as_uint(pmax), false, false);
    pmax = fmaxf(__uint_as_float(rr[0]), __uint_as_float(rr[1])); }
  if (__builtin_expect(__all(pmax - m_reg <= THR / SC), 1)) { mn = m_reg; alpha = 1.f; }
  else { mn = fmaxf(m_reg, pmax); alpha = __builtin_amdgcn_exp2f((m_reg - mn) * C); m_reg = mn; }
  const float mnC = -mn * C;
  AT_SBAR();
  asm volatile("v_mfma_scale_f32_32x32x64_f8f6f4 %0, %1, %2, %0, %3, %3 op_sel_hi:[0,0,0]" : "+v"(o[2]) : "v"(p8), "v"(v[2]), "v"(scl));
#pragma unroll
  for (int r = 0; r < 16; ++r) p0[r] = fmaf(p0[r], C, mnC);
#pragma unroll
  for (int r = 0; r < 16; ++r) p1[r] = fmaf(p1[r], C, mnC);
  AT_SBAR();
  asm volatile("v_mfma_scale_f32_32x32x64_f8f6f4 %0, %1, %2, %0, %3, %3 op_sel_hi:[0,0,0]" : "+v"(o[3]) : "v"(p8), "v"(v[3]), "v"(scl));
#pragma unroll
  for (int r = 0; r < 16; ++r) p0[r] = __builtin_amdgcn_exp2f(p0[r]);
  AT_SBAR();
}
template <int DQK>
__device__ __forceinline__ void qkt8(f32x16& p0, f32x16& p1, const LAS char* kb, const LAS char* kbp, const v8i* q8, int scl) {
  constexpr int RP8 = DQK + 16, NS = DQK / 64;
  v8i a0[NS], a1[NS];
#pragma unroll
  for (int s = 0; s < NS; ++s) {
    const LAS char* c0 = (DQK == 192 && s == 2) ? kbp : kb + 64 * s; const int d2 = (DQK == 192 && s == 2) ? 32 : 16;
    a0[s] = __builtin_shufflevector(*(const LAS v4i*)(c0), *(const LAS v4i*)(c0 + d2), 0, 1, 2, 3, 4, 5, 6, 7);
    a1[s] = __builtin_shufflevector(*(const LAS v4i*)(c0 + 32 * RP8), *(const LAS v4i*)(c0 + 32 * RP8 + d2), 0, 1, 2, 3, 4, 5, 6, 7); }
  asm volatile("v_mfma_scale_f32_32x32x64_f8f6f4 %0, %1, %2, 0, %3, %3 op_sel_hi:[0,0,0]" : "=&v"(p0) : "v"(a0[0]), "v"(q8[0]), "v"(scl));
  asm volatile("v_mfma_scale_f32_32x32x64_f8f6f4 %0, %1, %2, 0, %3, %3 op_sel_hi:[0,0,0]" : "=&v"(p1) : "v"(a1[0]), "v"(q8[0]), "v"(scl));
  if constexpr (NS == 3) {
    asm volatile("v_mfma_scale_f32_32x32x64_f8f6f4 %0, %1, %2, %0, %3, %3 op_sel_hi:[0,0,0]" : "+v"(p0) : "v"(a0[1]), "v"(q8[1]), "v"(scl));
    asm volatile("v_mfma_scale_f32_32x32x64_f8f6f4 %0, %1, %2, %0, %3, %3 op_sel_hi:[0,0,0]" : "+v"(p1) : "v"(a1[1]), "v"(q8[1]), "v"(scl)); }
  asm volatile("v_mfma_scale_f32_32x32x64_f8f6f4 %0, %2, %4, %0, %5, %5 op_sel_hi:[0,0,0]\n\tv_mfma_scale_f32_32x32x64_f8f6f4 %1, %3, %4, %1, %5, %5 op_sel_hi:[0,0,0]\n\ts_nop 15\n\ts_nop 15"
               : "+v"(p0), "+v"(p1) : "v"(a0[NS - 1]), "v"(a1[NS - 1]), "v"(q8[NS - 1]), "v"(scl));
}
__device__ __forceinline__ v8i pack32_fp8(const float (&x)[32]) { v8i r;
#pragma unroll
  for (int q = 0; q < 8; ++q) r[q] = (int)cvt4_fp8(x[4 * q], x[4 * q + 1], x[4 * q + 2], x[4 * q + 3]);
  return r; }
__device__ __forceinline__ void ld16_bf16(const bf16_t* p, float* x) {
  const u32x4 r0 = *reinterpret_cast<const u32x4*>(p), r1 = *reinterpret_cast<const u32x4*>(p + 8);
#pragma unroll
  for (int j = 0; j < 4; ++j) { x[2 * j] = bf_lo(r0[j]); x[2 * j + 1] = bf_hi(r0[j]); x[8 + 2 * j] = bf_lo(r1[j]); x[8 + 2 * j + 1] = bf_hi(r1[j]); } }
__device__ __forceinline__ int v_st(int k, int c) { const int kk = (k & ~0xC) | ((k & 4) << 1) | ((k & 8) >> 1); return ((kk >> 3) * 4 + (c >> 5)) * 512 + ((kk & 7) * 32 + (c & 31)) * 2; }
__device__ __forceinline__ int v_rd_base(int lane) { return ((lane & 3) << 3) | (((lane >> 2) & 3) << 6) | (((lane >> 4) & 1) << 5) | (((lane >> 5) & 1) << 8); }
constexpr int v_rd_off(int d0, int ks, int half) { return d0 * 512 + ks * 4096 + half * 2048; }
template <int OFF> __device__ __forceinline__ s16x4 tr_read(int vb) {
  s16x4 r; asm volatile("ds_read_b64_tr_b16 %0, %1 offset:%2" : "=&v"(r) : "v"(vb), "i"(OFF) : "memory"); return r;
}
template <int D0> __device__ __forceinline__ void pv_one(f32x16& od, int vb, bf16x8 pa0, bf16x8 pa1, bf16x8 pa2, bf16x8 pa3) {
  const s16x4 l0 = tr_read<v_rd_off(D0, 0, 0)>(vb), h0 = tr_read<v_rd_off(D0, 0, 1)>(vb), l1 = tr_read<v_rd_off(D0, 1, 0)>(vb), h1 = tr_read<v_rd_off(D0, 1, 1)>(vb);
  const s16x4 l2 = tr_read<v_rd_off(D0, 2, 0)>(vb), h2 = tr_read<v_rd_off(D0, 2, 1)>(vb), l3 = tr_read<v_rd_off(D0, 3, 0)>(vb), h3 = tr_read<v_rd_off(D0, 3, 1)>(vb);
  asm volatile("s_waitcnt lgkmcnt(0)" ::: "memory"); AT_SBAR();
#define AT_PK(L, H) (bf16x8){L[0], L[1], L[2], L[3], H[0], H[1], H[2], H[3]}
  od = __builtin_amdgcn_mfma_f32_32x32x16_bf16(pa0, AT_PK(l0, h0), od, 0, 0, 0);
  od = __builtin_amdgcn_mfma_f32_32x32x16_bf16(pa1, AT_PK(l1, h1), od, 0, 0, 0);
  od = __builtin_amdgcn_mfma_f32_32x32x16_bf16(pa2, AT_PK(l2, h2), od, 0, 0, 0);
  od = __builtin_amdgcn_mfma_f32_32x32x16_bf16(pa3, AT_PK(l3, h3), od, 0, 0, 0);
#undef AT_PK
}
__device__ __forceinline__ void pv_d0(f32x16* o, int vb, bf16x8 pa0, bf16x8 pa1, bf16x8 pa2, bf16x8 pa3) {
  pv_one<0>(o[0], vb, pa0, pa1, pa2, pa3); pv_one<1>(o[1], vb, pa0, pa1, pa2, pa3); pv_one<2>(o[2], vb, pa0, pa1, pa2, pa3); pv_one<3>(o[3], vb, pa0, pa1, pa2, pa3);
}

template <int DQK, int SDEPTH, int QM, int ldq, int ldk, int ldv, int ldo, bool O8 = false>
__device__ __forceinline__ void attn_body(const bf16_t* __restrict__ Qb, const bf16_t* __restrict__ Kn, const bf16_t* __restrict__ Kp,
                                          const bf16_t* __restrict__ Vh, bf16_t* __restrict__ Ob, int seq, LAS char* lds,
                                          bool rope, int pos0, const float* __restrict__ qg, const float* __restrict__ tcos, const float* __restrict__ tsin, int wv) {
  constexpr int RBP = DQK * 2 + 16, SHM_V = KVBLK * 128 * 2, SHM_K = KVBLK * RBP, ND = DQK / 16;
  const int lane = lane_id(), wid = wv, tid = wv * 64 + lane;
  const int r32 = lane & 31, hi = lane >> 5;
  LAS char* V_lds = lds; LAS char* K_lds = lds + 2 * SHM_V;
  LAS float* ws = (LAS float*)(lds + 2 * SHM_V + 2 * SHM_K) + wid * 64; LAS float* li_l = ws; LAS float* al_l = ws + 32;
  float m_reg = -1e30f, l_reg = 0; f32x16 o[4] = {}; bf16x8 qr[ND];
  {
    const bf16_t* Qw = Qb + (size_t)(wid * QBLK + r32) * ldq + hi * 8;
    const int spos = pos0 + wid * QBLK + r32;
    if constexpr (QM == 0) {
      float xf[8][8]; float ss = 0.f;
#pragma unroll
      for (int d0 = 0; d0 < 8; ++d0) { const u32x4 raw = *reinterpret_cast<const u32x4*>(Qw + d0 * 16);
#pragma unroll
        for (int j = 0; j < 4; ++j) { xf[d0][2 * j] = bf_lo(raw[j]); xf[d0][2 * j + 1] = bf_hi(raw[j]); }
#pragma unroll
        for (int j = 0; j < 8; ++j) ss += xf[d0][j] * xf[d0][j]; }
      ss += __shfl_xor(ss, 32);
      const float rstd = rsqrtf(ss * (1.f / 128.f) + EPS);
#pragma unroll
      for (int d0 = 0; d0 < 8; ++d0) { const f32x4 g0 = *reinterpret_cast<const f32x4*>(qg + d0 * 16 + hi * 8), g1 = *reinterpret_cast<const f32x4*>(qg + d0 * 16 + hi * 8 + 4);
#pragma unroll
        for (int j = 0; j < 4; ++j) { xf[d0][j] *= rstd * g0[j]; xf[d0][4 + j] *= rstd * g1[j]; } }
      if (rope) {
#pragma unroll
        for (int d0 = 0; d0 < 4; ++d0) { const float* tc = tcos + (size_t)spos * 64 + d0 * 16 + hi * 8; const float* tsn = tsin + (size_t)spos * 64 + d0 * 16 + hi * 8;
          const f32x4 c0 = *reinterpret_cast<const f32x4*>(tc), c1 = *reinterpret_cast<const f32x4*>(tc + 4), s0 = *reinterpret_cast<const f32x4*>(tsn), s1 = *reinterpret_cast<const f32x4*>(tsn + 4);
#pragma unroll
          for (int j = 0; j < 8; ++j) { const float c = j < 4 ? c0[j & 3] : c1[j & 3], s = j < 4 ? s0[j & 3] : s1[j & 3];
            const float x1 = xf[d0][j], x2 = xf[d0 + 4][j]; xf[d0][j] = x1 * c - x2 * s; xf[d0 + 4][j] = x1 * s + x2 * c; } }
      }
#pragma unroll
      for (int d0 = 0; d0 < 8; ++d0) { u32x4 w = {cvt_pk_bf16(xf[d0][0], xf[d0][1]), cvt_pk_bf16(xf[d0][2], xf[d0][3]), cvt_pk_bf16(xf[d0][4], xf[d0][5]), cvt_pk_bf16(xf[d0][6], xf[d0][7])};
        qr[d0] = *reinterpret_cast<bf16x8*>(&w); }
    } else {
#pragma unroll
      for (int d0 = 0; d0 < 8; ++d0) qr[d0] = *reinterpret_cast<const bf16x8*>(Qw + d0 * 16);
      float xf[4][8];
#pragma unroll
      for (int d0 = 0; d0 < 4; ++d0) { const u32x4 raw = *reinterpret_cast<const u32x4*>(Qw + 128 + d0 * 16);
#pragma unroll
        for (int j = 0; j < 4; ++j) { xf[d0][2 * j] = bf_lo(raw[j]); xf[d0][2 * j + 1] = bf_hi(raw[j]); } }
      if (rope) {
#pragma unroll
        for (int d0 = 0; d0 < 2; ++d0) { const float* tc = tcos + (size_t)spos * 32 + d0 * 16 + hi * 8; const float* tsn = tsin + (size_t)spos * 32 + d0 * 16 + hi * 8;
          const f32x4 c0 = *reinterpret_cast<const f32x4*>(tc), c1 = *reinterpret_cast<const f32x4*>(tc + 4), s0 = *reinterpret_cast<const f32x4*>(tsn), s1 = *reinterpret_cast<const f32x4*>(tsn + 4);
#pragma unroll
          for (int j = 0; j < 8; ++j) { const float c = j < 4 ? c0[j & 3] : c1[j & 3], s = j < 4 ? s0[j & 3] : s1[j & 3];
            const float x1 = xf[d0][j], x2 = xf[d0 + 2][j]; xf[d0][j] = x1 * c - x2 * s; xf[d0 + 2][j] = x1 * s + x2 * c; } }
      }
#pragma unroll
      for (int d0 = 0; d0 < 4; ++d0) { u32x4 w = {cvt_pk_bf16(xf[d0][0], xf[d0][1]), cvt_pk_bf16(xf[d0][2], xf[d0][3]), cvt_pk_bf16(xf[d0][4], xf[d0][5]), cvt_pk_bf16(xf[d0][6], xf[d0][7])};
        qr[8 + d0] = *reinterpret_cast<bf16x8*>(&w); }
    }
  }
  const int sr = tid >> 4, sc = (tid & 15) * 8, vst0 = v_st(sr, sc), vst1 = v_st(32 + sr, sc);
  const int pr = tid >> 3, pc = (tid & 7) * 8;
  const int vb0 = (int)(uintptr_t)V_lds + v_rd_base(lane);
  const LAS char* kb0 = K_lds + r32 * RBP + hi * 16;
  const int kst = sr * RBP + sc * 2, kpst = pr * RBP + (128 + pc) * 2;
  const unsigned voK = (unsigned)(sr * ldk + sc) * 2u, voV = (unsigned)(sr * ldv + sc) * 2u, voP = (unsigned)(pr * 64 + pc) * 2u;
  const char* Kc = (const char*)Kn; const char* Vc = (const char*)Vh; const char* Pc = (const char*)Kp;
  struct { bf16x8 vs0, vs1, ks0, ks1, kp; } sr_[SDEPTH];
#define AT_SLOAD(i, k0) do { const char* vb_ = Vc + (size_t)(k0) * (ldv * 2); const char* kb_ = Kc + (size_t)(k0) * (ldk * 2); \
    sr_[i].vs0 = *reinterpret_cast<const bf16x8*>(vb_ + voV); sr_[i].vs1 = *reinterpret_cast<const bf16x8*>(vb_ + 32 * ldv * 2 + voV); \
    sr_[i].ks0 = *reinterpret_cast<const bf16x8*>(kb_ + voK); sr_[i].ks1 = *reinterpret_cast<const bf16x8*>(kb_ + 32 * ldk * 2 + voK); \
    if constexpr (DQK == 192) sr_[i].kp = *reinterpret_cast<const bf16x8*>(Pc + (size_t)(k0) * 128 + voP); } while (0)
#define AT_SWRITE(b, i) do { *(LAS bf16x8*)(V_lds + (b) * SHM_V + vst0) = sr_[i].vs0; *(LAS bf16x8*)(V_lds + (b) * SHM_V + vst1) = sr_[i].vs1; \
    *(LAS bf16x8*)(K_lds + (b) * SHM_K + kst) = sr_[i].ks0; *(LAS bf16x8*)(K_lds + (b) * SHM_K + 32 * RBP + kst) = sr_[i].ks1; \
    if constexpr (DQK == 192) *(LAS bf16x8*)(K_lds + (b) * SHM_K + kpst) = sr_[i].kp; } while (0)
#define AT_SWAIT() do { if constexpr (SDEPTH == 2) { if constexpr (DQK == 192) asm volatile("s_waitcnt vmcnt(5)" ::: "memory"); else asm volatile("s_waitcnt vmcnt(4)" ::: "memory"); } \
    else asm volatile("s_waitcnt vmcnt(0)" ::: "memory"); } while (0)
#define AT_RESC(a) do { if (__any((a) < 1.f)) { if (hi == 0) al_l[r32] = (a); asm volatile("s_waitcnt lgkmcnt(0)" ::: "memory"); \
    _Pragma("unroll") for (int d = 0; d < 4; ++d) _Pragma("unroll") for (int r = 0; r < 16; ++r) o[d][r] *= al_l[crow(r, hi)]; } } while (0)
  f32x16 pA0, pA1, pB0, pB1; float mnA, mnB, alA, alB; bf16x8 pa0, pa1, pa2, pa3; const int NT = seq / KVBLK;
  constexpr int SE = 0, SO = SDEPTH - 1;
  AT_SLOAD(SE, 0); asm volatile("s_waitcnt vmcnt(0)" ::: "memory"); AT_SWRITE(0, SE); __syncthreads();
  qkt<DQK>(pA0, pA1, kb0, qr); partialSM<QM>(pA0, pA1, m_reg, mnA, alA);
  AT_SLOAD(SO, KVBLK); if constexpr (SDEPTH == 2) { if (2 < NT) AT_SLOAD(SE, 2 * KVBLK); }
  AT_SWAIT(); AT_SWRITE(1, SO); __syncthreads();
  for (int j = 1; j + 1 < NT; j += 2) {
    AT_SBAR(); qkt<DQK>(pB0, pB1, kb0 + SHM_K, qr);
    finishSM(pA0, pA1, alA, l_reg, pa0, pa1, pa2, pa3); AT_SBAR();
    AT_SLOAD(SO, (j + SDEPTH) * KVBLK); AT_SBAR();
    pv_d0(o, vb0, pa0, pa1, pa2, pa3); partialSM<QM>(pB0, pB1, m_reg, mnB, alB);
    __syncthreads(); AT_SWAIT(); AT_SWRITE(0, SE);
    AT_RESC(alB); __syncthreads();
    AT_SBAR(); qkt<DQK>(pA0, pA1, kb0, qr);
    finishSM(pB0, pB1, alB, l_reg, pa0, pa1, pa2, pa3); AT_SBAR();
    if (SDEPTH == 1 || j + 3 < NT) AT_SLOAD(SE, (j + 1 + SDEPTH) * KVBLK); AT_SBAR();
    pv_d0(o, vb0 + SHM_V, pa0, pa1, pa2, pa3); partialSM<QM>(pA0, pA1, m_reg, mnA, alA);
    __syncthreads(); AT_SWAIT(); AT_SWRITE(1, SO);
    AT_RESC(alA); __syncthreads();
  }
  AT_SBAR(); qkt<DQK>(pB0, pB1, kb0 + SHM_K, qr);
  finishSM(pA0, pA1, alA, l_reg, pa0, pa1, pa2, pa3); AT_SBAR();
  pv_d0(o, vb0, pa0, pa1, pa2, pa3); partialSM<QM>(pB0, pB1, m_reg, mnB, alB);
  __syncthreads(); AT_RESC(alB);
  finishSM(pB0, pB1, alB, l_reg, pa0, pa1, pa2, pa3); AT_SBAR();
  pv_d0(o, vb0 + SHM_V, pa0, pa1, pa2, pa3);
  if (hi == 0) li_l[r32] = l_reg; asm volatile("s_waitcnt lgkmcnt(0)" ::: "memory");
  float rli[16];
#pragma unroll
  for (int r = 0; r < 16; ++r) rli[r] = __builtin_amdgcn_rcpf(li_l[crow(r, hi)]);
  if constexpr (O8) {
    unsigned char* Ow = (unsigned char*)Ob + (size_t)(wid * QBLK) * ldo;
#pragma unroll
    for (int r = 0; r < 16; ++r) { const int orow = crow(r, hi);
#pragma unroll
      for (int d0 = 0; d0 < 4; ++d0) { const float v = o[d0][r] * rli[r] * 16.f; Ow[(size_t)orow * ldo + d0 * 32 + r32] = (unsigned char)(cvt4_fp8(v, 0.f, 0.f, 0.f) & 0xffu); } }
  } else {
  bf16_t* Ow = Ob + (size_t)(wid * QBLK) * ldo;
#pragma unroll
  for (int r = 0; r < 16; ++r) { const int orow = crow(r, hi);
#pragma unroll
    for (int d0 = 0; d0 < 4; ++d0) Ow[(size_t)orow * ldo + d0 * 32 + r32] = (bf16_t)(cvt_pk_bf16(o[d0][r] * rli[r], 0.f) & 0xffffu); }
  }
  __syncthreads();
#undef AT_SLOAD
#undef AT_SWRITE
#undef AT_SWAIT
#undef AT_RESC
}

template <int DQK, int QM, int ldq, int ldk8, int ldo, bool O8, int SDEPTH>
__device__ __forceinline__ void attn_body8(const bf16_t* __restrict__ Qb, const unsigned char* __restrict__ Kn8, const unsigned char* __restrict__ Kp8,
                                           const unsigned char* __restrict__ Vt8, bf16_t* __restrict__ Ob, int seq, LAS char* lds,
                                           bool rope, int pos0, const float* __restrict__ qg, const float* __restrict__ tcos, const float* __restrict__ tsin, int wv) {
  constexpr int RP8 = DQK + 16, RPV = KVBLK + 16, SHM_V = 128 * RPV, SHM_K = KVBLK * RP8, NS = DQK / 64;
  const int lane = lane_id(), wid = wv, tid = wv * 64 + lane;
  const int r32 = lane & 31, hi = lane >> 5;
  LAS char* V_lds = lds; LAS char* K_lds = lds + 3 * SHM_V;
  LAS float* ws = (LAS float*)(lds + 3 * SHM_V + 3 * SHM_K) + wid * 64; LAS float* li_l = ws; LAS float* al_l = ws + 32;
  float m_reg = -1e30f, l_reg = 0; f32x16 o[4] = {}; v8i q8[NS];
  int scl = 0x7F7F7F7F; asm volatile("" : "+v"(scl));
  {
    const bf16_t* Qw = Qb + (size_t)(wid * QBLK + r32) * ldq;
    const int spos = pos0 + wid * QBLK + r32;
    float x0[32], x1[32];
    ld16_bf16(Qw + 32 * hi, x0); ld16_bf16(Qw + 32 * hi + 16, x0 + 16); ld16_bf16(Qw + 64 + 32 * hi, x1); ld16_bf16(Qw + 64 + 32 * hi + 16, x1 + 16);
    if constexpr (QM == 0) {
      float ss = 0.f;
#pragma unroll
      for (int t = 0; t < 32; ++t) ss += x0[t] * x0[t] + x1[t] * x1[t];
      ss += __shfl_xor(ss, 32);
      const float rstd = rsqrtf(ss * (1.f / 128.f) + EPS);
#pragma unroll
      for (int t = 0; t < 32; t += 4) { const f32x4 g0 = *reinterpret_cast<const f32x4*>(qg + 32 * hi + t), g1 = *reinterpret_cast<const f32x4*>(qg + 64 + 32 * hi + t);
#pragma unroll
        for (int j = 0; j < 4; ++j) { x0[t + j] *= rstd * g0[j]; x1[t + j] *= rstd * g1[j]; } }
      if (rope) {
#pragma unroll
        for (int t = 0; t < 32; t += 4) { const f32x4 c = *reinterpret_cast<const f32x4*>(tcos + (size_t)spos * 64 + 32 * hi + t), sn = *reinterpret_cast<const f32x4*>(tsin + (size_t)spos * 64 + 32 * hi + t);
#pragma unroll
          for (int j = 0; j < 4; ++j) { const float a = x0[t + j], b = x1[t + j]; x0[t + j] = a * c[j] - b * sn[j]; x1[t + j] = a * sn[j] + b * c[j]; } }
      }
      q8[0] = pack32_fp8(x0); q8[1] = pack32_fp8(x1);
    } else {
      q8[0] = pack32_fp8(x0); q8[1] = pack32_fp8(x1);
      float pe[32];
      ld16_bf16(Qw + 128 + 16 * hi, pe); ld16_bf16(Qw + 128 + 32 + 16 * hi, pe + 16);
      if (rope) {
#pragma unroll
        for (int t = 0; t < 16; t += 4) { const f32x4 c = *reinterpret_cast<const f32x4*>(tcos + (size_t)spos * 32 + 16 * hi + t), sn = *reinterpret_cast<const f32x4*>(tsin + (size_t)spos * 32 + 16 * hi + t);
#pragma unroll
          for (int j = 0; j < 4; ++j) { const float a = pe[t + j], b = pe[16 + t + j]; pe[t + j] = a * c[j] - b * sn[j]; pe[16 + t + j] = a * sn[j] + b * c[j]; } }
      }
      q8[NS - 1] = pack32_fp8(pe);
    }
  }
  const int vcol = tid >> 2, vpart = (tid & 3) * 16;
  const int kr = tid >> 3, kc = (tid & 7) * 16;
  const int pr = (tid & 255) >> 2, pc = (tid & 3) * 16;
  const LAS char* vb0 = V_lds + r32 * RPV + 32 * hi;
  const LAS char* kb0 = K_lds + r32 * RP8 + 32 * hi; const LAS char* kbp0 = K_lds + r32 * RP8 + 128 + 16 * hi;
  const int kst = kr * RP8 + kc, kpst = pr * RP8 + 128 + pc;
  const unsigned voV = (unsigned)(vcol * RPB + vpart), voK = (unsigned)(kr * ldk8 + kc), voP = (unsigned)(pr * 64 + pc);
  const char* Kc = (const char*)Kn8; const char* Vc = (const char*)Vt8; const char* Pc = (const char*)Kp8;
  struct { v4i vt, k8, kp8; } sr_[SDEPTH];
#define AT_SLOAD(i, k0) do { sr_[i].vt = *reinterpret_cast<const v4i*>(Vc + (size_t)(k0) + voV); \
    sr_[i].k8 = *reinterpret_cast<const v4i*>(Kc + (size_t)(k0) * ldk8 + voK); \
    if constexpr (DQK == 192) sr_[i].kp8 = *reinterpret_cast<const v4i*>(Pc + (size_t)(k0) * 64 + voP); } while (0)
#define AT_SWRITE(b, i) do { *(LAS v4i*)(V_lds + (b) * SHM_V + vcol * RPV + vpart) = sr_[i].vt; \
    *(LAS v4i*)(K_lds + (b) * SHM_K + kst) = sr_[i].k8; \
    if constexpr (DQK == 192) { if (tid < 256) *(LAS v4i*)(K_lds + (b) * SHM_K + kpst) = sr_[i].kp8; } } while (0)
#define AT_SWAIT() do { if constexpr (SDEPTH == 1) asm volatile("s_waitcnt vmcnt(0)" ::: "memory"); else if constexpr (DQK == 192) asm volatile("s_waitcnt vmcnt(3)" ::: "memory"); else asm volatile("s_waitcnt vmcnt(2)" ::: "memory"); } while (0)
#define AT_RESC(a) do { if (__any((a) < 1.f)) { if (hi == 0) al_l[r32] = (a); asm volatile("s_nop 15\n\ts_nop 15\n\ts_waitcnt lgkmcnt(0)" ::: "memory"); \
    _Pragma("unroll") for (int d = 0; d < 4; ++d) _Pragma("unroll") for (int r = 0; r < 16; ++r) o[d][r] *= al_l[crow(r, hi)]; } } while (0)
  f32x16 pA0, pA1, pB0, pB1; float mnA, mnB, alA, alB; v8i p8; const int NT = seq / KVBLK;
  static_assert(SDEPTH == 2, "the three-buffer loop stages two tiles ahead");
  constexpr int SE = 0, SO = 1;
  AT_SLOAD(SE, 0); asm volatile("s_waitcnt vmcnt(0)" ::: "memory"); AT_SWRITE(0, SE); __syncthreads();
  qkt8<DQK>(pA0, pA1, kb0, kbp0, q8, scl); partialSM<QM, 5>(pA0, pA1, m_reg, mnA, alA);
  AT_SLOAD(SO, KVBLK); AT_SLOAD(SE, (2 < NT ? 2 : NT - 1) * KVBLK);
  AT_SWAIT(); AT_SWRITE(1, SO); __syncthreads();
  int bf = 1;
  for (int j = 1; j + 1 < NT; j += 2) {
    const int b1 = bf == 2 ? 0 : bf + 1, b2 = b1 == 2 ? 0 : b1 + 1, bm1 = bf == 0 ? 2 : bf - 1;
    AT_SBAR(); qkt8<DQK>(pB0, pB1, kb0 + bf * SHM_K, kbp0 + bf * SHM_K, q8, scl);
    finishSM8(pA0, pA1, alA, l_reg, p8); AT_SBAR();
    AT_SLOAD(SO, (j + 2) * KVBLK); AT_SBAR();
    pv8_psm<QM, 5>(o, vb0 + bm1 * SHM_V, p8, scl, pB0, pB1, m_reg, mnB, alB);
    AT_SWAIT(); AT_SWRITE(b1, SE);
    AT_RESC(alB); __syncthreads();
    AT_SBAR(); qkt8<DQK>(pA0, pA1, kb0 + b1 * SHM_K, kbp0 + b1 * SHM_K, q8, scl);
    finishSM8(pB0, pB1, alB, l_reg, p8); AT_SBAR();
    AT_SLOAD(SE, (j + 3 < NT ? j + 3 : NT - 1) * KVBLK); AT_SBAR();
    pv8_psm<QM, 5>(o, vb0 + bf * SHM_V, p8, scl, pA0, pA1, m_reg, mnA, alA);
    AT_SWAIT(); AT_SWRITE(b2, SO);
    AT_RESC(alA); __syncthreads();
    bf = b2;
  }
  { const int bm1 = bf == 0 ? 2 : bf - 1;
    AT_SBAR(); qkt8<DQK>(pB0, pB1, kb0 + bf * SHM_K, kbp0 + bf * SHM_K, q8, scl);
    finishSM8(pA0, pA1, alA, l_reg, p8); AT_SBAR();
    pv8_psm<QM, 5>(o, vb0 + bm1 * SHM_V, p8, scl, pB0, pB1, m_reg, mnB, alB);
    AT_RESC(alB);
    finishSM8(pB0, pB1, alB, l_reg, p8); AT_SBAR();
    pv8(o, vb0 + bf * SHM_V, p8, scl); }
  if (hi == 0) li_l[r32] = l_reg; asm volatile("s_waitcnt lgkmcnt(0)" ::: "memory");
  float rli[16];
#pragma unroll
  for (int r = 0; r < 16; ++r) rli[r] = __builtin_amdgcn_rcpf(li_l[crow(r, hi)]);
  if constexpr (O8) {
    unsigned char* Ow = (unsigned char*)Ob + (size_t)(wid * QBLK) * ldo;
#pragma unroll
    for (int r = 0; r < 16; ++r) { const int orow = crow(r, hi);
#pragma unroll
      for (int d0 = 0; d0 < 4; ++d0) { const float v = o[d0][r] * rli[r] * 16.f; Ow[(size_t)orow * ldo + d0 * 32 + r32] = (unsigned char)(cvt4_fp8(v, 0.f, 0.f, 0.f) & 0xffu); } }
  } else {
    bf16_t* Ow = Ob + (size_t)(wid * QBLK) * ldo;
#pragma unroll
    for (int r = 0; r < 16; ++r) { const int orow = crow(r, hi);
#pragma unroll
      for (int d0 = 0; d0 < 4; ++d0) Ow[(size_t)orow * ldo + d0 * 32 + r32] = (bf16_t)(cvt_pk_bf16(o[d0][r] * rli[r], 0.f) & 0xffffu); }
  }
  __syncthreads();
#undef AT_SLOAD
#undef AT_SWRITE
#undef AT_SWAIT
#undef AT_RESC
}
}

static_assert(WS_END < (size_t)1230 * 1000 * 1000, "workspace budget");

__device__ __forceinline__ const float* mod_ptr(const Params& p, int l) { return (const float*)(p.ws + WS_MOD) + (size_t)l * 9 * 12288; }

__device__ __forceinline__ void cvt_job(const float* __restrict__ src, int K, int N, bf16_t* __restrict__ dst, int drows, int mode, const float* __restrict__ scale, int T, LAS unsigned char* lds, int t) {
    const int ntn = (N + 127) >> 7, tpe = (K >> 6) * ntn;
    const int e = T / tpe, rem = T - e * tpe, kt = rem / ntn, nt_ = rem - kt * ntn, n0 = nt_ * 128, k0 = kt * 64;
    int drow0 = n0;
    if (mode == 1) drow0 = (n0 >> 7) * 256;
    else if (mode == 2) drow0 = (n0 >> 7) * 256 + 128;
    else if (mode == 3) drow0 = n0 < 1536 ? n0 : (n0 < 2560 ? 1536 + ((n0 - 1536) >> 7) * 256 : 1536 + ((n0 - 2560) >> 7) * 256 + 128);
    const int lk = t >> 5, ln4 = (t & 31) * 4;
    const float* sp = src + (size_t)e * K * N + (size_t)(k0 + lk) * N + n0 + ln4;
    f32x4 v[4];
    const bool inb = (n0 + ln4) < N;
#pragma unroll
    for (int i = 0; i < 4; ++i) v[i] = inb ? __builtin_nontemporal_load((const f32x4*)(sp + (size_t)(16 * i) * N)) : (f32x4){0.f, 0.f, 0.f, 0.f};
    if (scale) {
#pragma unroll
        for (int i = 0; i < 4; ++i) v[i] *= scale[k0 + lk + 16 * i];
    }
#pragma unroll
    for (int i = 0; i < 4; ++i)
#pragma unroll
        for (int j = 0; j < 4; ++j) *(LAS bf16_t*)(lds + (ln4 + j) * 132 + (lk + 16 * i) * 2) = (bf16_t)(cvt_pk_bf16(v[i][j], 0.f) & 0xffffu);
    __syncthreads();
    const int n = t >> 2, kq = (t & 3) * 16;
    unsigned w[8];
#pragma unroll
    for (int q = 0; q < 8; ++q) w[q] = *(const LAS unsigned*)(lds + n * 132 + kq * 2 + q * 4);
    if (n0 + n < N) { bf16_t* d = dst + (size_t)e * drows * K + (size_t)(drow0 + n) * K + k0 + kq;
        u32x4 a = {w[0], w[1], w[2], w[3]}, b = {w[4], w[5], w[6], w[7]}; *(u32x4*)d = a; *(u32x4*)(d + 8) = b; }
    __syncthreads();
}
__device__ __forceinline__ void cvt_job_f8(const float* __restrict__ src, int K, int N, unsigned char* __restrict__ dst, int drows, int mode, const float* __restrict__ scale, int T, LAS unsigned char* lds, int t) {
    const int ntn = (N + 127) >> 7, tpe = (K >> 7) * ntn;
    const int e = T / tpe, rem = T - e * tpe, kt = rem / ntn, nt_ = rem - kt * ntn, n0 = nt_ * 128, k0 = kt * 128;
    int drow0 = n0;
    if (mode == 1) drow0 = (n0 >> 7) * 256;
    else if (mode == 2) drow0 = (n0 >> 7) * 256 + 128;
    else if (mode == 3) drow0 = n0 < 1536 ? n0 : (n0 < 2560 ? 1536 + ((n0 - 1536) >> 7) * 256 : 1536 + ((n0 - 2560) >> 7) * 256 + 128);
    const int lk = (t >> 5) * 8, ln4 = (t & 31) * 4;
    const float* sp = src + (size_t)e * K * N + (size_t)(k0 + lk) * N + n0 + ln4;
    const bool inb = (n0 + ln4) < N;
    f32x4 v[8];
#pragma unroll
    for (int i = 0; i < 8; ++i) v[i] = inb ? __builtin_nontemporal_load((const f32x4*)(sp + (size_t)i * N)) * 32.f : (f32x4){0.f, 0.f, 0.f, 0.f};
    if (scale) {
#pragma unroll
        for (int i = 0; i < 8; ++i) v[i] *= scale[k0 + lk + i];
    }
#pragma unroll
    for (int j = 0; j < 4; ++j) {
        const unsigned w0 = cvt4_fp8(v[0][j], v[1][j], v[2][j], v[3][j]), w1 = cvt4_fp8(v[4][j], v[5][j], v[6][j], v[7][j]);
        *(LAS unsigned*)(lds + (ln4 + j) * 132 + lk) = w0; *(LAS unsigned*)(lds + (ln4 + j) * 132 + lk + 4) = w1; }
    __syncthreads();
    const int n = t >> 2, kq = (t & 3) * 32;
    unsigned w[8];
#pragma unroll
    for (int q = 0; q < 8; ++q) w[q] = *(const LAS unsigned*)(lds + n * 132 + kq + q * 4);
    if (n0 + n < N) { unsigned char* d = dst + (size_t)e * drows * K + (size_t)(drow0 + n) * K + k0 + kq;
      u32x4 a = {w[0], w[1], w[2], w[3]}, b = {w[4], w[5], w[6], w[7]}; *(u32x4*)d = a; *(u32x4*)(d + 16) = b; }
    __syncthreads();
}
struct CvtD { const float* sp; const float* sc; unsigned char* d; int N; bool inb, stv; };
__device__ __forceinline__ void cvt8_desc(const float* __restrict__ src, int K, int N, unsigned char* __restrict__ dst, int drows, int mode, const float* __restrict__ scale, int T, int t, CvtD& q) {
    const int ntn = (N + 127) >> 7, tpe = (K >> 7) * ntn;
    const int e = T / tpe, rem = T - e * tpe, kt = rem / ntn, nt_ = rem - kt * ntn, n0 = nt_ * 128, k0 = kt * 128;
    int drow0 = n0;
    if (mode == 1) drow0 = (n0 >> 7) * 256;
    else if (mode == 2) drow0 = (n0 >> 7) * 256 + 128;
    else if (mode == 3) drow0 = n0 < 1536 ? n0 : (n0 < 2560 ? 1536 + ((n0 - 1536) >> 7) * 256 : 1536 + ((n0 - 2560) >> 7) * 256 + 128);
    const int lk = (t >> 5) * 8, ln4 = (t & 31) * 4;
    q.inb = (n0 + ln4) < N; q.N = N;
    q.sp = src + (size_t)e * K * N + (size_t)(k0 + lk) * N + (q.inb ? n0 + ln4 : 0);
    q.sc = scale ? scale + k0 + lk : nullptr;
    const int n = t >> 2, kq = (t & 3) * 32;
    q.stv = n0 + n < N; q.d = dst + (size_t)e * drows * K + (size_t)(drow0 + n) * K + k0 + kq;
}
__device__ __forceinline__ void cvt8_load(const CvtD& q, f32x4 (&v)[8]) {
#pragma unroll
    for (int i = 0; i < 8; ++i) v[i] = __builtin_nontemporal_load((const f32x4*)(q.sp + (size_t)i * q.N));
}
__device__ __forceinline__ void cvt8_finish(const CvtD& q, f32x4 (&v)[8], LAS unsigned char* lds, int t) {
    const int lk = (t >> 5) * 8, ln4 = (t & 31) * 4;
#pragma unroll
    for (int i = 0; i < 8; ++i) v[i] = q.inb ? v[i] * 32.f : (f32x4){0.f, 0.f, 0.f, 0.f};
    if (q.sc) {
#pragma unroll
        for (int i = 0; i < 8; ++i) v[i] *= q.sc[i];
    }
#pragma unroll
    for (int j = 0; j < 4; ++j) {
        const unsigned w0 = cvt4_fp8(v[0][j], v[1][j], v[2][j], v[3][j]), w1 = cvt4_fp8(v[4][j], v[5][j], v[6][j], v[7][j]);
        *(LAS unsigned*)(lds + (ln4 + j) * 132 + lk) = w0; *(LAS unsigned*)(lds + (ln4 + j) * 132 + lk + 4) = w1; }
    __syncthreads();
    const int n = t >> 2, kq = (t & 3) * 32;
    unsigned w[8];
#pragma unroll
    for (int qq = 0; qq < 8; ++qq) w[qq] = *(const LAS unsigned*)(lds + n * 132 + kq + qq * 4);
    if (q.stv) { u32x4 a = {w[0], w[1], w[2], w[3]}, b = {w[4], w[5], w[6], w[7]}; *(u32x4*)q.d = a; *(u32x4*)(q.d + 16) = b; }
    __syncthreads();
}
constexpr int CVT_ALL = 6144 + 960 + 944 + 6144, CVT_EAGER = CVT_ALL - (2304 + 768 + 384 + 840);
constexpr int P0_MOD = 768, P0_PAD = 48, P0_ROPE = 384, P0_ITEMS = P0_MOD + P0_PAD + P0_ROPE + CVT_EAGER;
__device__ __forceinline__ void cvt_item(const Params& p, int T, LAS unsigned char* lds, int t) {
    bf16_t* W = (bf16_t*)(p.ws + WS_W); unsigned char* W8 = (unsigned char*)W;
    if (T < 2048) { cvt_job_f8(p.in[17], 2048, 1024, W8 + W_GU0 * 2, 2048, 1, nullptr, T, lds, t); return; } T -= 2048;
    if (T < 2048) { cvt_job_f8(p.in[18], 2048, 1024, W8 + W_GU0 * 2, 2048, 2, nullptr, T, lds, t); return; } T -= 2048;
    if (T < 2048) { cvt_job_f8(p.in[19], 1024, 2048, W8 + W_DN0 * 2, 2048, 0, nullptr, T, lds, t); return; } T -= 2048;
    if (T < 448) { cvt_job_f8(p.in[7], 2048, 3584, W8 + W_IN0 * 2, 3584, 3, nullptr, T, lds, t); return; } T -= 448;
    if (T < 512) { cvt_job(p.in[14], 2048, 2048, W + W_OUT0, 2048, 0, nullptr, T, lds, t); return; } T -= 512;
    if (T < 272) { cvt_job_f8(p.in[23], 2048, 2112, W8 + W_DQKV * 2, 2304, 0, nullptr, T, lds, t); return; } T -= 272;
    if (T < 288) { cvt_job_f8(p.in[25], 1536, 3072, W8 + W_UQ * 2, 3072, 0, p.in[24], T, lds, t); return; } T -= 288;
    if (T < 128) { cvt_job_f8(p.in[27], 512, 4096, W8 + W_UKV * 2, 4096, 0, p.in[26], T, lds, t); return; } T -= 128;
    if (T < 256) { cvt_job_f8(p.in[28], 2048, 2048, W8 + W_OUT1 * 2, 2048, 0, nullptr, T, lds, t); return; } T -= 256;
    if (T < 2048) { cvt_job_f8(p.in[31], 2048, 1024, W8 + W_GU1 * 2, 2048, 1, nullptr, T, lds, t); return; } T -= 2048;
    if (T < 2048) { cvt_job_f8(p.in[32], 2048, 1024, W8 + W_GU1 * 2, 2048, 2, nullptr, T, lds, t); return; } T -= 2048;
    cvt_job_f8(p.in[33], 1024, 2048, W8 + W_DN1 * 2, 2048, 0, nullptr, T, lds, t);
}
__device__ __forceinline__ void cvt8_item_desc(const Params& p, int T, int t, CvtD& q) {
    unsigned char* W8 = (unsigned char*)(p.ws + WS_W);
    if (T < 2048) { cvt8_desc(p.in[17], 2048, 1024, W8 + W_GU0 * 2, 2048, 1, nullptr, T, t, q); return; } T -= 2048;
    if (T < 2048) { cvt8_desc(p.in[18], 2048, 1024, W8 + W_GU0 * 2, 2048, 2, nullptr, T, t, q); return; } T -= 2048;
    if (T < 2048) { cvt8_desc(p.in[19], 1024, 2048, W8 + W_DN0 * 2, 2048, 0, nullptr, T, t, q); return; } T -= 2048;
    if (T < 448) { cvt8_desc(p.in[7], 2048, 3584, W8 + W_IN0 * 2, 3584, 3, nullptr, T, t, q); return; } T -= 448 + 512;
    if (T < 272) { cvt8_desc(p.in[23], 2048, 2112, W8 + W_DQKV * 2, 2304, 0, nullptr, T, t, q); return; } T -= 272;
    if (T < 288) { cvt8_desc(p.in[25], 1536, 3072, W8 + W_UQ * 2, 3072, 0, p.in[24], T, t, q); return; } T -= 288;
    if (T < 128) { cvt8_desc(p.in[27], 512, 4096, W8 + W_UKV * 2, 4096, 0, p.in[26], T, t, q); return; } T -= 128;
    if (T < 256) { cvt8_desc(p.in[28], 2048, 2048, W8 + W_OUT1 * 2, 2048, 0, nullptr, T, t, q); return; } T -= 256;
    if (T < 2048) { cvt8_desc(p.in[31], 2048, 1024, W8 + W_GU1 * 2, 2048, 1, nullptr, T, t, q); return; } T -= 2048;
    if (T < 2048) { cvt8_desc(p.in[32], 2048, 1024, W8 + W_GU1 * 2, 2048, 2, nullptr, T, t, q); return; } T -= 2048;
    cvt8_desc(p.in[33], 1024, 2048, W8 + W_DN1 * 2, 2048, 0, nullptr, T, t, q);
}
__device__ __forceinline__ void cvt_tail(const Params& p, int lo, int hi, int first, LAS unsigned char* lds, int wv) {
    const int c = blockIdx.x, G = gridDim.x;
    if (c < first) return;
    const int t = TID_OF(wv), st = G - first;
    int T = lo + (c - first);
    if (T < hi) {
        CvtD qc, qn; f32x4 vc[8], vn[8];
        cvt8_item_desc(p, T, t, qc); cvt8_load(qc, vc);
        for (; T < hi; T += st) {
            const int Tn = T + st < hi ? T + st : T;
            cvt8_item_desc(p, Tn, t, qn); cvt8_load(qn, vn);
            cvt8_finish(qc, vc, lds, t);
            qc = qn;
#pragma unroll
            for (int i = 0; i < 8; ++i) vc[i] = vn[i];
        }
    }
}

__device__ __forceinline__ void phase_prep(const Params& p, LAS unsigned char* lds, int wv) {
    const int t = TID_OF(wv);
    bf16_t* W = (bf16_t*)(p.ws + WS_W);
    constexpr int CVT_BF0 = 6144 + 448, CVT_NBF = 512, P0_FIRST = P0_MOD + P0_PAD + P0_ROPE + CVT_NBF;
    for (int it = blockIdx.x; it < P0_FIRST; it += gridDim.x) {
        if (it < P0_MOD) {
            const int l = it / 384, rem = it - l * 384, kc = rem / 12, cc = rem - kc * 12;
            LAS float* sl = (LAS float*)lds;
            __syncthreads();
            for (int i = t; i < 9 * 64; i += NTHR) { const int r = i >> 6, k = kc * 64 + (i & 63); const float v = r < 8 ? p.in[1][r * D + k] : p.in[3][k]; sl[i] = v * sigmoid_f(v); }
            __syncthreads();
            const float* w = p.in[l == 0 ? 4 : 20] + (size_t)(kc * 64) * 12288 + cc * 1024 + t * 2;
            float a0[9], a1[9];
#pragma unroll
            for (int r = 0; r < 9; ++r) { a0[r] = 0.f; a1[r] = 0.f; }
            f32x2 wv2[2][8];
#pragma unroll
            for (int j = 0; j < 8; ++j) wv2[0][j] = __builtin_nontemporal_load((const f32x2*)(w + (size_t)j * 12288));
#pragma unroll
            for (int s8 = 0; s8 < 8; ++s8) {
                if (s8 + 1 < 8) {
#pragma unroll
                    for (int j = 0; j < 8; ++j) wv2[(s8 + 1) & 1][j] = __builtin_nontemporal_load((const f32x2*)(w + (size_t)((s8 + 1) * 8 + j) * 12288)); }
                __builtin_amdgcn_sched_barrier(0);
#pragma unroll
                for (int j = 0; j < 8; ++j)
#pragma unroll
                    for (int r = 0; r < 9; ++r) { const float s = sl[r * 64 + s8 * 8 + j]; a0[r] += s * wv2[s8 & 1][j].x; a1[r] += s * wv2[s8 & 1][j].y; }
            }
            float* mp = (float*)(p.ws + WS_MODP) + ((size_t)(l * 32 + kc) * 9) * 12288 + cc * 1024 + t * 2;
#pragma unroll
            for (int r = 0; r < 9; ++r) { f32x2 o; o.x = a0[r]; o.y = a1[r]; *(f32x2*)(mp + (size_t)r * 12288) = o; }
            __syncthreads();
        } else if (it < P0_MOD + P0_PAD) {
            const int i = (it - P0_MOD) * NTHR + t;
            u32x4 z = {0u, 0u, 0u, 0u};
            *(u32x4*)((unsigned char*)W + W_DQKV * 2 + (size_t)2112 * D + (size_t)i * 16) = z;
        } else if (it < P0_MOD + P0_PAD + P0_ROPE) {
            const int i = (it - P0_MOD - P0_PAD) * NTHR + t;
            float* rp = (float*)(p.ws + WS_ROPE);
            if (i < 2048 * 64) { const int s = i >> 6, j = i & 63; const float pos = j < 32 ? (float)(s >> 6) : (float)(s & 63);
                const float inv = powf(10000.f, -(float)(j & 31) / 32.f); const float ang = pos * inv;
                rp[i] = cosf(ang); rp[2048 * 64 + i] = sinf(ang); }
            else { const int i2 = i - 2048 * 64, s = i2 >> 5, j = i2 & 31; const float pos = j < 16 ? (float)(s >> 6) : (float)(s & 63);
                const float inv = powf(10000.f, -(float)(j & 15) / 16.f); const float ang = pos * inv;
                rp[2 * 2048 * 64 + i2] = cosf(ang); rp[2 * 2048 * 64 + 2048 * 32 + i2] = sinf(ang); }
        } else {
            cvt_item(p, CVT_BF0 + it - (P0_MOD + P0_PAD + P0_ROPE), lds, t);
        }
    }
    {
        constexpr int NJ = CVT_EAGER - CVT_NBF;
        const int G = gridDim.x; int j = (int)((blockIdx.x + G - (unsigned)(P0_FIRST % G)) % G);
        if (j < NJ) {
            CvtD qc, qn; f32x4 vc[8], vn[8];
            cvt8_item_desc(p, j < CVT_BF0 ? j : j + CVT_NBF, t, qc); cvt8_load(qc, vc);
            for (; j < NJ; j += G) {
                const int jn = j + G < NJ ? j + G : j;
                cvt8_item_desc(p, jn < CVT_BF0 ? jn : jn + CVT_NBF, t, qn); cvt8_load(qn, vn);
                cvt8_finish(qc, vc, lds, t);
                qc = qn;
#pragma unroll
                for (int i = 0; i < 8; ++i) vc[i] = vn[i];
            }
        }
    }
    __syncthreads();
}

__device__ __forceinline__ void phase_modreduce(const Params& p, int wv) {
    const float* mp = (const float*)(p.ws + WS_MODP); float* mod = (float*)(p.ws + WS_MOD);
    for (int i4 = blockIdx.x * NTHR + TID_OF(wv); i4 < 2 * 9 * 12288 / 4; i4 += gridDim.x * NTHR) {
        const int i = i4 * 4, l = i / (9 * 12288), rem = i - l * 9 * 12288, n = rem % 12288;
        f32x4 pv[32];
#pragma unroll
        for (int kc = 0; kc < 32; ++kc) pv[kc] = *(const f32x4*)(mp + (size_t)(l * 32 + kc) * 9 * 12288 + rem);
        f32x4 s = *(const f32x4*)(p.in[l == 0 ? 5 : 21] + n);
#pragma unroll
        for (int kc = 0; kc < 32; ++kc) s += pv[kc];
        *(f32x4*)(mod + i) = s;
    }
}

__device__ __forceinline__ void norm_mod_store(const f32x4 (&xv)[8], float rstd, const float* __restrict__ g, const float* __restrict__ sc, const float* __restrict__ sh, bf16_t* __restrict__ hrow, int lane) {
#pragma unroll
    for (int i = 0; i < 8; ++i) { const int k = i * 256 + lane * 4;
        const f32x4 gv = *(const f32x4*)(g + k), sv = *(const f32x4*)(sc + k), tv = *(const f32x4*)(sh + k);
        const f32x4 y = xv[i] * rstd * gv * (1.f + sv) + tv;
        u32x2 w; w.x = cvt_pk_bf16(y[0], y[1]); w.y = cvt_pk_bf16(y[2], y[3]); *(u32x2*)(hrow + k) = w; }
}
__device__ __forceinline__ float row_sumsq(const f32x4 (&xv)[8]) {
    float ss = 0.f;
#pragma unroll
    for (int i = 0; i < 8; ++i) ss += xv[i][0] * xv[i][0] + xv[i][1] * xv[i][1] + xv[i][2] * xv[i][2] + xv[i][3] * xv[i][3];
    return wave_sum(ss);
}

__device__ __forceinline__ void phase_norm1_l0(const Params& p, int wv) {
    const int lane = lane_id(), wid = wv;
    const float* mod = mod_ptr(p, 0); bf16_t* H = (bf16_t*)(p.ws + WS_H);
    const int nw = gridDim.x * 8, gw = blockIdx.x * 8 + wid, grp = gw % 9, wi = gw / 9, nwi = (nw - grp + 8) / 9;
    f32x4 gm[8], tv[8];
    { const float* sc = mod + (size_t)grp * 12288 + 1 * D; const float* sh = mod + (size_t)grp * 12288 + 0 * D;
#pragma unroll
      for (int i = 0; i < 8; ++i) { const int k = i * 256 + lane * 4; gm[i] = *(const f32x4*)(p.in[6] + k) * (1.f + *(const f32x4*)(sc + k)); tv[i] = *(const f32x4*)(sh + k); } }
    const float* srcb = grp < 8 ? p.in[0] + (size_t)grp * SEQ * D : p.in[2];
#define P2_ROW(i_) (grp < 8 ? grp * RPB + CL + (i_) : ((i_) >> 8) * RPB + ((i_) & 255))
    f32x4 xv[8];
#pragma unroll
    for (int i = 0; i < 8; ++i) xv[i] = *(const f32x4*)(srcb + (size_t)wi * D + i * 256 + lane * 4);
    for (int it = wi; it < 2048; it += nwi) {
        const int itn = it + nwi < 2048 ? it + nwi : it; f32x4 xn[8];
#pragma unroll
        for (int i = 0; i < 8; ++i) xn[i] = *(const f32x4*)(srcb + (size_t)itn * D + i * 256 + lane * 4);
        const float rstd = rsqrtf(row_sumsq(xv) * (1.f / D) + EPS);
        unsigned char* hrow = (unsigned char*)H + (size_t)P2_ROW(it) * D;
#pragma unroll
        for (int i = 0; i < 8; ++i) { const int k = i * 256 + lane * 4; const f32x4 y = xv[i] * rstd * gm[i] + tv[i];
            *(unsigned*)(hrow + k) = cvt4_fp8(y[0], y[1], y[2], y[3]); }
#pragma unroll
        for (int i = 0; i < 8; ++i) xv[i] = xn[i];
    }
#undef P2_ROW
}

__device__ __forceinline__ void phase_kprep(const Params& p, int wv) {
    const int lane = lane_id(), wid = wv;
    const bf16_t* proj = (const bf16_t*)(p.ws + WS_R3 + R3_PROJ);
    const float* tc = (const float*)(p.ws + WS_ROPE); const float* tsn = tc + 2048 * 64;
    const float kg1 = p.in[9][lane], kg2 = p.in[9][64 + lane];
    const int nw = gridDim.x * 8;
    for (int rb = blockIdx.x * 8 + wid; rb < M; rb += 3 * nw) {
        float xa[3][2], xb[3][2], cc[3], ss[3];
#pragma unroll
        for (int u = 0; u < 3; ++u) { const int r = rb + u * nw;
            if (r < M) { const int b = r / RPB, o = r - b * RPB, s = o >= CL ? o - CL : 0; const bf16_t* prow = proj + (size_t)r * QKVW + 1024;
#pragma unroll
                for (int kh = 0; kh < 2; ++kh) { xa[u][kh] = bf2f(prow[kh * 128 + lane]); xb[u][kh] = bf2f(prow[kh * 128 + 64 + lane]); }
                cc[u] = tc[(size_t)s * 64 + lane]; ss[u] = tsn[(size_t)s * 64 + lane]; } }
#pragma unroll
        for (int u = 0; u < 3; ++u) { const int r = rb + u * nw;
            if (r < M) { const int b = r / RPB, o = r - b * RPB; const bool lat = o >= CL;
#pragma unroll
                for (int kh = 0; kh < 2; ++kh) {
                    const float x1 = xa[u][kh], x2 = xb[u][kh];
                    const float rstd = rsqrtf(wave_sum(x1 * x1 + x2 * x2) * (1.f / 128.f) + EPS);
                    float y1 = x1 * rstd * kg1, y2 = x2 * rstd * kg2;
                    if (lat) { const float c = cc[u], sn = ss[u]; const float o1 = y1 * c - y2 * sn, o2 = y1 * sn + y2 * c; y1 = o1; y2 = o2; }
                    unsigned char* k8 = (unsigned char*)(p.ws + WS_K8G) + (size_t)r * 256 + kh * 128;
                    k8[lane] = (unsigned char)(cvt4_fp8(y1, 0.f, 0.f, 0.f) & 0xffu); k8[64 + lane] = (unsigned char)(cvt4_fp8(y2, 0.f, 0.f, 0.f) & 0xffu);
                } } }
    }
}

template <int T>
__device__ __forceinline__ void conv_item(const Params& p, int row0, LAS unsigned char* lds, int wv) {
    constexpr int NR = T + 30, NQ = (NR * 128 + NTHR - 1) / NTHR;
    const int t = TID_OF(wv);
    const bf16_t* ug = (const bf16_t*)(p.ws + WS_R3 + R3_UG); bf16_t* cat = (bf16_t*)(p.ws + WS_CAT);
    const int b = row0 / RPB, o = row0 - b * RPB;
    const int seq_lo = o < CL ? b * RPB : b * RPB + CL, seq_hi = o < CL ? b * RPB + CL : (b + 1) * RPB;
    { u32x4 tv[NQ];
#pragma unroll
      for (int q = 0; q < NQ; ++q) { const int c = t + q * NTHR, rr = (c >> 7) < NR ? (c >> 7) : NR - 1, cc = (c & 127) * 8, gr = row0 - 15 + rr;
          const int grc = gr < seq_lo ? seq_lo : (gr >= seq_hi ? seq_hi - 1 : gr); tv[q] = *(const u32x4*)(ug + (size_t)grc * 1024 + cc); }
#pragma unroll
      for (int q = 0; q < NQ; ++q) { const int c = t + q * NTHR, rr = c >> 7, cc = (c & 127) * 8, gr = row0 - 15 + rr;
          const bool in = gr >= seq_lo && gr < seq_hi; const u32x4 v = in ? tv[q] : (u32x4){0u, 0u, 0u, 0u};
          if (c < NR * 128) *(LAS u32x4*)(lds + rr * 2048 + cc * 2) = v; } }
    __syncthreads();
    float w0[31], w1[31], a0[T], a1[T];
#pragma unroll
    for (int jj = 0; jj < 31; ++jj) { const f32x2 wv = *(const f32x2*)(p.in[10] + jj * 1024 + 2 * t); w0[jj] = wv.x; w1[jj] = wv.y; }
    { const f32x2 bv = *(const f32x2*)(p.in[11] + 2 * t);
#pragma unroll
      for (int k = 0; k < T; ++k) { a0[k] = bv.x; a1[k] = bv.y; } }
#pragma unroll
    for (int rr = 0; rr < NR; ++rr) { const unsigned v = *(const LAS unsigned*)(lds + rr * 2048 + t * 4); const float x0 = bf_lo(v), x1 = bf_hi(v);
#pragma unroll
        for (int tok = (rr - 30 > 0 ? rr - 30 : 0); tok <= (rr < T - 1 ? rr : T - 1); ++tok) { a0[tok] += w0[rr - tok] * x0; a1[tok] += w1[rr - tok] * x1; } }
    __syncthreads();
    LAS float* part = (LAS float*)lds;
#pragma unroll
    for (int k = 0; k < T; ++k) { part[k * 512 + t] = a0[k] + a1[k]; part[(T + k) * 512 + t] = a0[k] * a0[k] + a1[k] * a1[k]; }
    __syncthreads();
    LAS float* stats = (LAS float*)(lds + IDX_OFF);
    { const int tok = t >> 4, sub = t & 15;
      if (tok < T) { float s1 = 0.f, s2 = 0.f;
#pragma unroll 8
        for (int k = 0; k < 32; ++k) { const int kk = (k + sub) & 31; s1 += part[tok * 512 + sub * 32 + kk]; s2 += part[(T + tok) * 512 + sub * 32 + kk]; }
#pragma unroll
        for (int of = 8; of; of >>= 1) { s1 += __shfl_xor(s1, of); s2 += __shfl_xor(s2, of); }
        const float mean = s1 * (1.f / 1024.f), var = s2 * (1.f / 1024.f) - mean * mean;
        if (sub == 0) { stats[tok * 2] = mean; stats[tok * 2 + 1] = rsqrtf(fmaxf(var, 0.f) + EPS); } } }
    __syncthreads();
    { const f32x2 gv = *(const f32x2*)(p.in[12] + 2 * t), bv = *(const f32x2*)(p.in[13] + 2 * t);
#pragma unroll
      for (int k = 0; k < T; ++k) { const float mean = stats[k * 2], rstd = stats[k * 2 + 1];
          const float y0 = (a0[k] - mean) * rstd * gv.x + bv.x, y1 = (a1[k] - mean) * rstd * gv.y + bv.y;
          *(unsigned*)(cat + (size_t)(row0 + k) * D + 1024 + 2 * t) = cvt_pk_bf16(silu_f(y0), silu_f(y1)); } }
    __syncthreads();
}

__device__ __forceinline__ void phase_attn0_conv(const Params& p, LAS unsigned char* lds, int wv) {
    const bf16_t* proj = (const bf16_t*)(p.ws + WS_R3 + R3_PROJ); bf16_t* cat = (bf16_t*)(p.ws + WS_CAT);
    const float* tc = (const float*)(p.ws + WS_ROPE); const float* tsn = tc + 2048 * 64;
#ifndef NO_ATT0
    for (int it = blockIdx.x; it < 576; it += gridDim.x) {
        {
            int b, hq, qb;
            if (it < 512) { b = it & 7; const int j = it >> 3; hq = j >> 3; qb = 1 + (j & 7); } else { const int i2 = it - 512; b = i2 & 7; hq = i2 >> 3; qb = 0; }
            const size_t row0 = (size_t)b * RPB, qrow0 = row0 + qb * 256; const int kvh = hq >> 2;
            at::attn_body8<128, 0, QKVW, 256, D, false, 2>(proj + qrow0 * QKVW + hq * 128, (const unsigned char*)(p.ws + WS_K8G) + row0 * 256 + kvh * 128, nullptr, (const unsigned char*)(p.ws + WS_VT8G) + (size_t)(b * 2 + kvh) * 128 * RPB,
                                     cat + qrow0 * D + hq * 128, qb == 0 ? CL : RPB, (LAS char*)lds, qb > 0, (qb - 1) * 256, p.in[8], tc, tsn, wv);
        }
    }
#endif
#ifndef NO_CONV
    for (int it = blockIdx.x; it < 512; it += gridDim.x) conv_item<32>(p, it * 32, lds, wv);
    { const int G = gridDim.x, h0 = G > 64 ? 64 : 0, nh = G - h0;
      if ((int)blockIdx.x >= h0) for (int h = blockIdx.x - h0; h < 128; h += nh) conv_item<16>(p, 512 * 32 + h * 16, lds, wv); }
#endif
}

typedef _Float16 half8 __attribute__((ext_vector_type(8)));
typedef _Float16 half2v __attribute__((ext_vector_type(2)));
__device__ __forceinline__ unsigned pk_f16(float a, float b) { const half2v h = __builtin_convertvector((f32x2){a, b}, half2v); return __builtin_bit_cast(unsigned, h); }
__device__ __forceinline__ void phase_n2router(const Params& p, int l, LAS unsigned char* lds, int wv) {
    const int lane = lane_id(), wid = wv, t = wv * 64 + lane, fr = lane & 15, fq = lane >> 4;
    const float* router = p.in[l == 0 ? 16 : 30]; const float* g2 = p.in[l == 0 ? 15 : 29];
    const float* mod = mod_ptr(p, l); const bf16_t* xres = (const bf16_t*)(p.ws + WS_XRES); unsigned char* H8 = (unsigned char*)(p.ws + WS_H);
    float* aff = (float*)(p.ws + WS_AFF); int* tokslot = (int*)(p.ws + WS_TOKSLOT);
    constexpr int RT_PITCH = 4112;
    constexpr int GM_OFF = 16 * RT_PITCH + 256 - (16 * RT_PITCH) % 256, TV_OFF = GM_OFF + 8192, SS_OFF = TV_OFF + 8192, PP_OFF = SS_OFF + 512;
    static_assert(PP_OFF + 8192 <= LDS_BYTES, "router LDS");
    { f32x4 ra[8], rb[8];
#pragma unroll
      for (int q = 0; q < 8; ++q) { const int i = t + q * NTHR, kp = i >> 2, e4 = (i & 3) * 4;
          ra[q] = *(const f32x4*)(router + (size_t)(2 * kp) * 16 + e4); rb[q] = *(const f32x4*)(router + (size_t)(2 * kp + 1) * 16 + e4); }
#pragma unroll
      for (int q = 0; q < 8; ++q) { const int i = t + q * NTHR, kp = i >> 2, e4 = (i & 3) * 4;
#pragma unroll
          for (int j = 0; j < 4; ++j) *(LAS unsigned*)(lds + (e4 + j) * RT_PITCH + kp * 4) = pk_f16(ra[q][j], rb[q][j]); } }
    LAS float* SS = (LAS float*)(lds + SS_OFF); LAS float* PP = (LAS float*)(lds + PP_OFF);
    const int c = blockIdx.x, G = gridDim.x, nblk = l == 0 ? M / 16 : NB * SEQ / 16;
    const int b0 = (int)((long)c * nblk / G), b1 = (int)((long)(c + 1) * nblk / G);
#define N2_ROW0(blk_) (l == 0 ? (blk_) * 16 : ((blk_) >> 7) * RPB + CL + ((blk_) & 127) * 16)
    u32x4 xs[8];
    if (b0 < b1) { const bf16_t* src = xres + (size_t)(N2_ROW0(b0) + fr) * D + 256 * wid + 8 * fq;
#pragma unroll
        for (int s = 0; s < 8; ++s) xs[s] = *(const u32x4*)(src + 32 * s); }
    int cur_grp = -1;
    for (int blk = b0; blk < b1; ++blk) {
        const int row0 = N2_ROW0(blk), bb = row0 / RPB, oo = row0 - bb * RPB, grp = (l == 0 && oo < CL) ? 8 : bb;
        u32x4 xn[8];
        { const int bn = blk + 1 < b1 ? blk + 1 : blk; const bf16_t* src = xres + (size_t)(N2_ROW0(bn) + fr) * D + 256 * wid + 8 * fq;
#pragma unroll
            for (int s = 0; s < 8; ++s) xn[s] = *(const u32x4*)(src + 32 * s); }
        if (grp != cur_grp) { cur_grp = grp;
            const float* sc = mod + (size_t)grp * 12288 + 4 * D; const float* sh = mod + (size_t)grp * 12288 + 3 * D; const int k = t * 4;
            *(LAS f32x4*)(lds + GM_OFF + k * 4) = *(const f32x4*)(g2 + k) * (1.f + *(const f32x4*)(sc + k)); *(LAS f32x4*)(lds + TV_OFF + k * 4) = *(const f32x4*)(sh + k); }
        float ss = 0.f;
#pragma unroll
        for (int s = 0; s < 8; ++s)
#pragma unroll
            for (int q = 0; q < 4; ++q) { const float lo = __uint_as_float(xs[s][q] << 16), hi = __uint_as_float(xs[s][q] & 0xffff0000u); ss += lo * lo + hi * hi; }
        ss += __shfl_xor(ss, 16); ss += __shfl_xor(ss, 32);
        if (fq == 0) SS[wid * 16 + fr] = ss;
        __syncthreads();
        float tot = 0.f;
#pragma unroll
        for (int w = 0; w < 8; ++w) tot += SS[w * 16 + fr];
        const float rstd = rsqrtf(tot * (1.f / D) + EPS);
        f32x4 acc = {0.f, 0.f, 0.f, 0.f};
        unsigned char* hrow = H8 + (size_t)(row0 + fr) * D + 256 * wid + 8 * fq;
#pragma unroll
        for (int s = 0; s < 8; ++s) { const int kk = 256 * wid + 32 * s + 8 * fq;
            const f32x4 g0 = *(const LAS f32x4*)(lds + GM_OFF + kk * 4), g1 = *(const LAS f32x4*)(lds + GM_OFF + kk * 4 + 16), t0 = *(const LAS f32x4*)(lds + TV_OFF + kk * 4), t1 = *(const LAS f32x4*)(lds + TV_OFF + kk * 4 + 16);
            f32x4 y0, y1;
            y0[0] = __uint_as_float(xs[s][0] << 16); y0[1] = __uint_as_float(xs[s][0] & 0xffff0000u); y0[2] = __uint_as_float(xs[s][1] << 16); y0[3] = __uint_as_float(xs[s][1] & 0xffff0000u);
            y1[0] = __uint_as_float(xs[s][2] << 16); y1[1] = __uint_as_float(xs[s][2] & 0xffff0000u); y1[2] = __uint_as_float(xs[s][3] << 16); y1[3] = __uint_as_float(xs[s][3] & 0xffff0000u);
            y0 = y0 * rstd * g0 + t0; y1 = y1 * rstd * g1 + t1;
            *(u32x2*)(hrow + 32 * s) = (u32x2){cvt4_fp8(y0[0], y0[1], y0[2], y0[3]), cvt4_fp8(y1[0], y1[1], y1[2], y1[3])};
            const u32x4 aw = {pk_f16(y0[0], y0[1]), pk_f16(y0[2], y0[3]), pk_f16(y1[0], y1[1]), pk_f16(y1[2], y1[3])};
            const half8 bf = *(const LAS half8*)(lds + fr * RT_PITCH + kk * 2);
            acc = __builtin_amdgcn_mfma_f32_16x16x32_f16(__builtin_bit_cast(half8, aw), bf, acc, 0, 0, 0); }
#pragma unroll
        for (int r = 0; r < 4; ++r) PP[(wid * 16 + 4 * fq + r) * 16 + fr] = acc[r];
        __syncthreads();
        if (t < 256) { const int row = t >> 4, e = t & 15; float lg = 0.f;
#pragma unroll
            for (int w = 0; w < 8; ++w) lg += PP[(w * 16 + row) * 16 + e];
            float mx = lg;
#pragma unroll
            for (int o = 1; o < 16; o <<= 1) mx = fmaxf(mx, __shfl_xor(mx, o));
            const float ex = expf(lg - mx); float sum = ex;
#pragma unroll
            for (int o = 1; o < 16; o <<= 1) sum += __shfl_xor(sum, o);
            aff[(size_t)(row0 + row) * 16 + e] = ex / sum; tokslot[(size_t)(row0 + row) * 16 + e] = -1; }
#pragma unroll
        for (int s = 0; s < 8; ++s) xs[s] = xn[s];
    }
#undef N2_ROW0
    __syncthreads();
}

__device__ __forceinline__ int block_count(LAS int* cnt, int par, bool f0, bool f1, bool f2, bool f3, int wid, int lane) {
    const int c = __popcll(__ballot(f0)) + __popcll(__ballot(f1)) + __popcll(__ballot(f2)) + __popcll(__ballot(f3));
    if (lane == 0) cnt[par * 8 + wid] = c;
    __syncthreads();
    int tot = 0;
#pragma unroll
    for (int w = 0; w < 8; ++w) tot += cnt[par * 8 + w];
    return tot;
}
__device__ __forceinline__ int block_prefix(LAS int* cnt, int par, bool f0, bool f1, bool f2, bool f3, int wid, int lane) {
    const unsigned long long lt = (1ull << lane) - 1ull;
    const unsigned long long b0 = __ballot(f0), b1 = __ballot(f1), b2 = __ballot(f2), b3 = __ballot(f3);
    const int below = __popcll(b0 & lt) + __popcll(b1 & lt) + __popcll(b2 & lt) + __popcll(b3 & lt);
    const int wtot = __popcll(b0) + __popcll(b1) + __popcll(b2) + __popcll(b3);
    if (lane == 0) cnt[par * 8 + wid] = wtot;
    __syncthreads();
    int base = 0;
#pragma unroll
    for (int w = 0; w < 8; ++w) base += (w < wid) ? cnt[par * 8 + w] : 0;
    return base + below;
}
__device__ __forceinline__ void phase_topk(const Params& p, int l, LAS unsigned char* lds, int wv) {
    const int lane = lane_id(), wid = wv, t = wv * 64 + lane;
    const float* aff = (const float*)(p.ws + WS_AFF); int* tokslot = (int*)(p.ws + WS_TOKSLOT); int* rowidx = (int*)(p.ws + WS_ROWIDX); float* gate = (float*)(p.ws + WS_GATE);
    const int nitems = l == 0 ? 256 : 128, rpg = l == 0 ? 2304 : 2048;
    LAS int* cnt = (LAS int*)lds;
    for (int it = blockIdx.x; it < nitems; it += gridDim.x) {
        const int set = it >> 4, e = it & 15; int b, n, cap, row0, sbase;
        if (set < 8) { b = set; n = SEQ; cap = 256; row0 = b * RPB + CL; sbase = b * 256; } else { b = set - 8; n = CL; cap = 32; row0 = b * RPB; sbase = 2048 + b * 32; }
        unsigned key[4]; bool valid[4];
#pragma unroll
        for (int q = 0; q < 4; ++q) { const int i = t * 4 + q; valid[q] = i < n; key[q] = valid[q] ? __float_as_uint(aff[(size_t)(row0 + i) * 16 + e]) : 0u; }
        unsigned K = 0u; int par = 0;
        for (int bit = 30; bit >= 0; --bit) {
            const unsigned cand = K | (1u << bit);
            const int c = block_count(cnt, par, valid[0] && key[0] >= cand, valid[1] && key[1] >= cand, valid[2] && key[2] >= cand, valid[3] && key[3] >= cand, wid, lane);
            par ^= 1;
            if (c >= cap) K = cand;
        }
        const int ngt = block_count(cnt, par, valid[0] && key[0] > K, valid[1] && key[1] > K, valid[2] && key[2] > K, valid[3] && key[3] > K, wid, lane); par ^= 1;
        const int need_eq = cap - ngt;
        bool eq[4], sel[4];
#pragma unroll
        for (int q = 0; q < 4; ++q) eq[q] = valid[q] && key[q] == K;
        int pe = block_prefix(cnt, par, eq[0], eq[1], eq[2], eq[3], wid, lane); par ^= 1;
#pragma unroll
        for (int q = 0; q < 4; ++q) { sel[q] = valid[q] && (key[q] > K || (eq[q] && pe < need_eq)); pe += eq[q] ? 1 : 0; }
        int ps = block_prefix(cnt, par, sel[0], sel[1], sel[2], sel[3], wid, lane); par ^= 1;
#pragma unroll
        for (int q = 0; q < 4; ++q) {
            if (sel[q]) { const int i = t * 4 + q, slot = sbase + ps; rowidx[e * rpg + slot] = row0 + i; gate[e * rpg + slot] = __uint_as_float(key[q]); tokslot[(size_t)(row0 + i) * 16 + e] = slot; ++ps; }
        }
        __syncthreads();
    }
    __syncthreads();
}

__device__ __forceinline__ float f8_to_f32(unsigned w, int byte) { float r;
    if (byte == 0) asm("v_cvt_f32_fp8 %0, %1 src0_sel:BYTE_0" : "=v"(r) : "v"(w)); else if (byte == 1) asm("v_cvt_f32_fp8 %0, %1 src0_sel:BYTE_1" : "=v"(r) : "v"(w));
    else if (byte == 2) asm("v_cvt_f32_fp8 %0, %1 src0_sel:BYTE_2" : "=v"(r) : "v"(w)); else asm("v_cvt_f32_fp8 %0, %1 src0_sel:BYTE_3" : "=v"(r) : "v"(w));
    return r; }
__device__ __forceinline__ void phase_combine(const Params& p, int l, int wv) {
    const int lane = lane_id(), wid = wv;
    bf16_t* xres = (bf16_t*)(p.ws + WS_XRES);
    const int* tokslot = (const int*)(p.ws + WS_TOKSLOT); const unsigned char* y = (const unsigned char*)(p.ws + WS_Y); const int rpg = l == 0 ? 2304 : 2048;
    const int nw = gridDim.x * 8, gw = blockIdx.x * 8 + wid, ngrp = l == 0 ? 9 : 8, grp = gw % ngrp, wi = gw / ngrp, nwi = (nw - grp + ngrp - 1) / ngrp;
    f32x4 ga[8], gm[8], tv[8];
    { const float* mod = mod_ptr(p, l); const float* mod1 = mod_ptr(p, 1);
#pragma unroll
      for (int i = 0; i < 8; ++i) { const int k = i * 256 + lane * 4; ga[i] = *(const f32x4*)(mod + (size_t)grp * 12288 + 5 * D + k) * (1.f / 32.f);
          if (l == 0) { gm[i] = *(const f32x4*)(p.in[22] + k) * (1.f + *(const f32x4*)(mod1 + (size_t)grp * 12288 + 1 * D + k)); tv[i] = *(const f32x4*)(mod1 + (size_t)grp * 12288 + 0 * D + k); }
          else { gm[i] = *(const f32x4*)(p.in[34] + k); tv[i] = (f32x4){0.f, 0.f, 0.f, 0.f}; } } }
#define CB_ROW(i_) (grp < 8 ? grp * RPB + CL + (i_) : ((i_) >> 8) * RPB + ((i_) & 255))
    f32x4 xv[8]; int myslot;
    { const int r = CB_ROW(wi);
#pragma unroll
      for (int i = 0; i < 8; ++i) xv[i] = bf4_to_f32(*(const u32x2*)(xres + (size_t)r * D + i * 256 + lane * 4));
      myslot = tokslot[(size_t)r * 16 + (lane & 15)]; }
    for (int it = wi; it < 2048; it += nwi) {
        const int r = CB_ROW(it), itn = it + nwi < 2048 ? it + nwi : it; u32x2 xn[8]; int nslot;
        { const int rn = CB_ROW(itn);
#pragma unroll
            for (int i = 0; i < 8; ++i) xn[i] = *(const u32x2*)(xres + (size_t)rn * D + i * 256 + lane * 4);
            nslot = tokslot[(size_t)rn * 16 + (lane & 15)]; }
        f32x4 ys[8];
#pragma unroll
        for (int i = 0; i < 8; ++i) ys[i] = (f32x4){0.f, 0.f, 0.f, 0.f};
        unsigned act = (unsigned)(__ballot(myslot >= 0) & 0xFFFFull);
        while (act) {
            const int e0 = __builtin_ctz(act); act &= act - 1u;
            const bool h1 = act != 0u; const int e1 = h1 ? __builtin_ctz(act) : 0; if (h1) act &= act - 1u;
            const bool h2 = act != 0u; const int e2 = h2 ? __builtin_ctz(act) : 0; if (h2) act &= act - 1u;
            const bool h3 = act != 0u; const int e3 = h3 ? __builtin_ctz(act) : 0; if (h3) act &= act - 1u;
            unsigned w0[8], w1[8], w2[8], w3[8];
#define CB_LOAD(W_, E_) { const unsigned char* yrow = y + ((size_t)(E_) * rpg + __builtin_amdgcn_readlane(myslot, (E_))) * D; \
                _Pragma("unroll") for (int i = 0; i < 8; ++i) W_[i] = *(const unsigned*)(yrow + i * 256 + lane * 4); }
#define CB_ACC(W_) { _Pragma("unroll") for (int i = 0; i < 8; ++i) { ys[i][0] += f8_to_f32(W_[i], 0); ys[i][1] += f8_to_f32(W_[i], 1); ys[i][2] += f8_to_f32(W_[i], 2); ys[i][3] += f8_to_f32(W_[i], 3); } }
            CB_LOAD(w0, e0)
            if (h1) CB_LOAD(w1, e1)
            if (h2) CB_LOAD(w2, e2)
            if (h3) CB_LOAD(w3, e3)
            CB_ACC(w0)
            if (h1) CB_ACC(w1)
            if (h2) CB_ACC(w2)
            if (h3) CB_ACC(w3)
#undef CB_LOAD
#undef CB_ACC
        }
#pragma unroll
        for (int i = 0; i < 8; ++i) xv[i] += ga[i] * ys[i];
        const float rstd = rsqrtf(row_sumsq(xv) * (1.f / D) + EPS);
        if (l == 0) {
            bf16_t* xrow = xres + (size_t)r * D; unsigned char* hrow = (unsigned char*)(p.ws + WS_H) + (size_t)r * D;
#pragma unroll
            for (int i = 0; i < 8; ++i) { const int k = i * 256 + lane * 4; *(u32x2*)(xrow + k) = (u32x2){cvt_pk_bf16(xv[i][0], xv[i][1]), cvt_pk_bf16(xv[i][2], xv[i][3])};
                const f32x4 yv = xv[i] * rstd * gm[i] + tv[i]; *(unsigned*)(hrow + k) = cvt4_fp8(yv[0], yv[1], yv[2], yv[3]); }
        } else {
            float* orow = p.out + (size_t)(grp * SEQ + it) * D;
#pragma unroll
            for (int i = 0; i < 8; ++i) { const int k = i * 256 + lane * 4; __builtin_nontemporal_store(xv[i] * rstd * gm[i], (f32x4*)(orow + k)); }
        }
#pragma unroll
        for (int i = 0; i < 8; ++i) xv[i] = bf4_to_f32(xn[i]);
        myslot = nslot;
    }
#undef CB_ROW
}

__device__ __forceinline__ float sumsq_f8x4(unsigned w) { const float a = f8_to_f32(w, 0), b = f8_to_f32(w, 1), c = f8_to_f32(w, 2), d = f8_to_f32(w, 3); return a * a + b * b + c * c + d * d; }
__device__ __forceinline__ void phase_l1prep(const Params& p, int wv) {
    const int lane = lane_id(), wid = wv;
    const unsigned char* z = (const unsigned char*)(p.ws + WS_R3 + R3_Z); float* rq = (float*)(p.ws + WS_RSTDQ); float* rkv = (float*)(p.ws + WS_RSTDKV); unsigned char* kpe = (unsigned char*)(p.ws + WS_KPE);
    const float* tc = (const float*)(p.ws + WS_ROPE) + 2 * 2048 * 64; const float* tsn = tc + 2048 * 32;
    const int nw = gridDim.x * 8;
    for (int rb = blockIdx.x * 8 + wid; rb < M; rb += 3 * nw) {
        u32x2 wkv[3], wq[3][3]; unsigned wpe[3]; f32x4 cs[3], sn[3];
#pragma unroll
        for (int u = 0; u < 3; ++u) { const int r = rb + u * nw;
            if (r < M) { const int b = r / RPB, o = r - b * RPB, s = o >= CL ? o - CL : 0; const unsigned char* zr = z + (size_t)r * ZW;
                wkv[u] = *(const u32x2*)(zr + QLORA + lane * 8);
#pragma unroll
                for (int i = 0; i < 3; ++i) wq[u][i] = *(const u32x2*)(zr + i * 512 + lane * 8);
                wpe[u] = *(const unsigned*)(zr + 2048 + (lane & 15) * 4);
                cs[u] = *(const f32x4*)(tc + (size_t)s * 32 + (lane & 7) * 4); sn[u] = *(const f32x4*)(tsn + (size_t)s * 32 + (lane & 7) * 4); } }
#pragma unroll
        for (int u = 0; u < 3; ++u) { const int r = rb + u * nw;
            if (r < M) { const int b = r / RPB, o = r - b * RPB; const bool lat = o >= CL;
                { float ss = sumsq_f8x4(wkv[u].x) + sumsq_f8x4(wkv[u].y);
                  ss = wave_sum(ss); if (lane == 0) rkv[r] = rsqrtf(ss * (1.f / KVLORA) + EPS); }
                if (lat) { float ss = 0.f;
#pragma unroll
                  for (int i = 0; i < 3; ++i) ss += sumsq_f8x4(wq[u][i].x) + sumsq_f8x4(wq[u][i].y);
                  ss = wave_sum(ss); if (lane == 0) rq[r] = rsqrtf(ss * (1.f / QLORA) + EPS); }
                { const unsigned wqp = wpe[u];
                  float x1[4], x2[4];
#pragma unroll
                  for (int q = 0; q < 4; ++q) x1[q] = f8_to_f32(wqp, q);
#pragma unroll
                  for (int q = 0; q < 4; ++q) x2[q] = __shfl(x1[q], (lane & 7) + 8);
                  if (lane < 8) {
#pragma unroll
                      for (int q = 0; q < 4; ++q) { const int i = lane * 4 + q; float a = x1[q], c2 = x2[q];
                          if (lat) { const float c = cs[u][q], sv = sn[u][q]; const float o1 = a * c - c2 * sv, o2 = a * sv + c2 * c; a = o1; c2 = o2; }
                          kpe[(size_t)r * 64 + i] = (unsigned char)(cvt4_fp8(a, 0.f, 0.f, 0.f) & 0xffu); kpe[(size_t)r * 64 + 32 + i] = (unsigned char)(cvt4_fp8(c2, 0.f, 0.f, 0.f) & 0xffu); } } }
            } }
    }
}

__device__ __forceinline__ void phase_attn1(const Params& p, LAS unsigned char* lds, int wv) {
    const bf16_t* q1 = (const bf16_t*)(p.ws + WS_R3 + R3_Q1); bf16_t* cat = (bf16_t*)(p.ws + WS_CAT);
    const float* tc = (const float*)(p.ws + WS_ROPE) + 2 * 2048 * 64; const float* tsn = tc + 2048 * 32;
    for (int it = blockIdx.x; it < 1024; it += gridDim.x) {
        const int b = it & 7, j = it >> 3, h = j >> 3, qb = 1 + (j & 7);
        const size_t row0 = (size_t)b * RPB, qrow0 = row0 + qb * 256, lrow0 = (size_t)b * SEQ + (qb - 1) * 256;
        at::attn_body8<192, 1, QW, 2048, D, true, 2>(q1 + lrow0 * QW + h * 192, (const unsigned char*)(p.ws + WS_K8N) + row0 * 2048 + h * 128, (const unsigned char*)(p.ws + WS_KPE) + row0 * 64, (const unsigned char*)(p.ws + WS_VT8N) + (size_t)(b * 16 + h) * 128 * RPB,
                                 (bf16_t*)((unsigned char*)cat + qrow0 * D + h * 128), RPB, (LAS char*)lds, true, (qb - 1) * 256, nullptr, tc, tsn, wv);
    }
}

__global__ void __launch_bounds__(NTHR, 2) mega(Params p) {
    extern __shared__ __attribute__((aligned(16))) unsigned char lds_raw[];
    LAS unsigned char* lds = (LAS unsigned char*)lds_raw;
    const int wv = __builtin_amdgcn_readfirstlane((int)(threadIdx.x >> 6));
    if (wv == 0) ((LAS unsigned*)(lds + MISC_OFF))[lane_id()] = 0u;
    __syncthreads();
    const bool multi = (p.ph_hi - p.ph_lo) > 1;
    XcdBarrier bar; bar.bar = (unsigned*)(p.ws + WS_CTL); bar.x = 0; bar.st = (volatile LAS unsigned*)(lds + MISC_OFF);
    if (multi) bar = xcd_barrier_post((unsigned*)(p.ws + WS_CTL), (volatile LAS unsigned*)(lds + MISC_OFF), wv);
#ifndef PH_MASK
#define PH_MASK 0xFFFFFFFFu
#endif
#define IN(k) ((((PH_MASK) >> (k)) & 1u) && p.ph_lo <= (k) && (k) < p.ph_hi)
#define SEAM(k) do { if (IN(k) && IN((k) + 1)) xcd_barrier(bar, wv); } while (0)
#ifndef REP_MASK
#define REP_MASK 0u
#endif
#define PHASE(k, ...) if (IN(k)) { __VA_ARGS__; if constexpr ((((REP_MASK) >> (k)) & 1u) != 0u) { if (multi) xcd_barrier(bar, wv); __VA_ARGS__; } }
#define WSP(T, off) ((T*)(p.ws + (off)))
    constexpr int TAIL0 = CVT_EAGER, TAIL1 = TAIL0 + 2304, TAIL2 = TAIL1 + 768, TAIL3 = TAIL2 + 384, TAIL4 = TAIL3 + 840;
    static_assert(TAIL4 == CVT_ALL, "tail ranges");
    const int G = gridDim.x, c = blockIdx.x;

    PHASE(0, phase_prep(p, lds, wv);)
    SEAM(0);
    PHASE(1, phase_modreduce(p, wv);)
    SEAM(1);
    PHASE(2, phase_norm1_l0(p, wv);)
    SEAM(2);
    PHASE(3, { gm::Sched S; S.init(MT, IN0W / 256, G, c, 0, 0); gm::EpiInProj E{WSP(bf16_t, WS_R3 + R3_PROJ), WSP(bf16_t, WS_R3 + R3_UG), WSP(unsigned char, WS_VT8G)};
        gm::gemm_phase<gm::EpiInProj, false, true>(lds, WSP(bf16_t, WS_H), D / 2, 0, WSP(bf16_t, WS_W) + W_IN0, D / 2, 0, S, E, nullptr, 0, wv); })
    SEAM(3);
    PHASE(4, phase_kprep(p, wv);)
    SEAM(4);
    PHASE(5, phase_attn0_conv(p, lds, wv);)
    SEAM(5);
    PHASE(6, { gm::Sched S; S.init(MT, D / 256, G, c, 0, 0); gm::EpiResid E{p.in[0], p.in[2], nullptr, WSP(bf16_t, WS_XRES), mod_ptr(p, 0) + 2 * D};
        gm::gemm_phase<gm::EpiResid, false>(lds, WSP(bf16_t, WS_CAT), D, 0, WSP(bf16_t, WS_W) + W_OUT0, D, 0, S, E, nullptr, 0, wv);
        cvt_tail(p, TAIL0, TAIL1, 64, lds, wv); })
    SEAM(6);
    PHASE(7, phase_n2router(p, 0, lds, wv);)
    SEAM(7);
    PHASE(8, phase_topk(p, 0, lds, wv);)
    SEAM(8);
    PHASE(9, { gm::Sched S; S.init(NE * 9, 8, G, c, 2, 9); gm::EpiSwiglu E{WSP(unsigned char, WS_CAT), 2304};
        gm::gemm_phase<gm::EpiSwiglu, true, true>(lds, WSP(bf16_t, WS_H), D / 2, 0, WSP(bf16_t, WS_W) + W_GU0, D / 2, (size_t)2048 * D / 2, S, E, WSP(const int, WS_ROWIDX), 2304, wv);
        cvt_tail(p, TAIL1, TAIL2, 128, lds, wv); })
    SEAM(9);
    PHASE(10, { gm::Sched S; S.init(NE * 9, 8, G, c, 2, 9); gm::EpiDown E{WSP(unsigned char, WS_Y), WSP(const float, WS_GATE), 2304};
        gm::gemm_phase<gm::EpiDown, false, true>(lds, WSP(bf16_t, WS_CAT), DF / 2, (size_t)2304 * DF / 2, WSP(bf16_t, WS_W) + W_DN0, DF / 2, (size_t)D * DF / 2, S, E, nullptr, 0, wv);
        cvt_tail(p, TAIL2, TAIL3, 128, lds, wv); })
    SEAM(10);
    PHASE(11, phase_combine(p, 0, wv);)
    SEAM(11);
    PHASE(12, { gm::Sched S; S.init(MT, ZW / 256, G, c, 0, 0); gm::EpiStoreF8 E{WSP(unsigned char, WS_R3 + R3_Z), ZW};
        gm::gemm_phase<gm::EpiStoreF8, false, true>(lds, WSP(bf16_t, WS_H), D / 2, 0, WSP(bf16_t, WS_W) + W_DQKV, D / 2, 0, S, E, nullptr, 0, wv);
        cvt_tail(p, TAIL3, TAIL4, 136, lds, wv); })
    SEAM(12);
    PHASE(13, phase_l1prep(p, wv);)
    SEAM(13);
    PHASE(14, {
        { gm::Sched S; S.init(64, QW / 256, G, c, 1, 0); gm::EpiStoreBf16 E{WSP(bf16_t, WS_R3 + R3_Q1), QW, WSP(const float, WS_RSTDQ), 1};
          gm::gemm_phase<gm::EpiStoreBf16, false, true>(lds, WSP(bf16_t, WS_R3 + R3_Z), ZW / 2, 0, WSP(bf16_t, WS_W) + W_UQ, QLORA / 2, 0, S, E, nullptr, 0, wv); }
        { gm::Sched S; S.init(MT, KVW / 256, G, c, 0, 0); gm::EpiKV E{WSP(unsigned char, WS_VT8N), WSP(unsigned char, WS_K8N), WSP(const float, WS_RSTDKV)};
          gm::gemm_phase<gm::EpiKV, false, true>(lds, (const bf16_t*)(WSP(unsigned char, WS_R3 + R3_Z) + QLORA), ZW / 2, 0, WSP(bf16_t, WS_W) + W_UKV, KVLORA / 2, 0, S, E, nullptr, 0, wv); }
    })
    SEAM(14);
    PHASE(15, phase_attn1(p, lds, wv);)
    SEAM(15);
    PHASE(16, { gm::Sched S; S.init(64, D / 256, G, c, 1, 0); gm::EpiResid E{nullptr, nullptr, WSP(const bf16_t, WS_XRES), WSP(bf16_t, WS_XRES), mod_ptr(p, 1) + 2 * D};
        gm::gemm_phase<gm::EpiResid, false, true>(lds, WSP(bf16_t, WS_CAT), D / 2, 0, WSP(bf16_t, WS_W) + W_OUT1, D / 2, 0, S, E, nullptr, 0, wv, 0x7B7B7B7B); })
    SEAM(16);
    PHASE(17, phase_n2router(p, 1, lds, wv);)
    SEAM(17);
    PHASE(18, phase_topk(p, 1, lds, wv);)
    SEAM(18);
    PHASE(19, { gm::Sched S; S.init(NE * 8, 8, G, c, 2, 8); gm::EpiSwiglu E{WSP(unsigned char, WS_CAT), 2048};
        gm::gemm_phase<gm::EpiSwiglu, true, true>(lds, WSP(bf16_t, WS_H), D / 2, 0, WSP(bf16_t, WS_W) + W_GU1, D / 2, (size_t)2048 * D / 2, S, E, WSP(const int, WS_ROWIDX), 2048, wv); })
    SEAM(19);
    PHASE(20, { gm::Sched S; S.init(NE * 8, 8, G, c, 2, 8); gm::EpiDown E{WSP(unsigned char, WS_Y), WSP(const float, WS_GATE), 2048};
        gm::gemm_phase<gm::EpiDown, false, true>(lds, WSP(bf16_t, WS_CAT), DF / 2, (size_t)2048 * DF / 2, WSP(bf16_t, WS_W) + W_DN1, DF / 2, (size_t)D * DF / 2, S, E, nullptr, 0, wv); })
    SEAM(20);
    PHASE(21, phase_combine(p, 1, wv);)
#undef IN
#undef SEAM
#undef PHASE
#undef WSP
}

extern "C" void kernel_launch(void* const* d_in, const int* in_sizes, int n_in, void* d_out, int out_size, void* d_ws, size_t ws_size, hipStream_t stream) {
    static int grid = 0;
    if (grid == 0) {
        if (n_in != 35 || in_sizes[0] != NB * SEQ * D || out_size != NB * SEQ * D || ws_size < WS_END) {
            fprintf(stderr, "kernel_launch: shape/workspace mismatch: n_in %d in0 %d out %d ws %zu (need %zu); nothing launched\n", n_in, n_in > 0 ? in_sizes[0] : -1, out_size, ws_size, (size_t)WS_END); grid = -1; return; }
        int dev = 0, cus = 0, per_cu = 0;
        if (hipGetDevice(&dev) != hipSuccess || hipDeviceGetAttribute(&cus, hipDeviceAttributeMultiprocessorCount, dev) != hipSuccess) { fprintf(stderr, "kernel_launch: device query failed\n"); grid = -1; return; }
        if (hipFuncSetAttribute((const void*)mega, hipFuncAttributeMaxDynamicSharedMemorySize, LDS_BYTES) != hipSuccess) { fprintf(stderr, "kernel_launch: hipFuncSetAttribute failed\n"); grid = -1; return; }
        if (hipOccupancyMaxActiveBlocksPerMultiprocessor(&per_cu, (const void*)mega, NTHR, LDS_BYTES) != hipSuccess || per_cu < 1) fprintf(stderr, "kernel_launch: note: occupancy query says %d\n", per_cu);
        (void)hipGetLastError();
        grid = cus;
    }
    if (grid < 0) return;
    if (hipMemsetAsync((char*)d_ws + WS_CTL, 0, CTL_BYTES, stream) != hipSuccess) { fprintf(stderr, "kernel_launch: memset failed\n"); return; }
    Params p{};
    for (int i = 0; i < 35; ++i) p.in[i] = (const float*)d_in[i];
    p.out = (float*)d_out; p.ws = (unsigned char*)d_ws;
#if MK_MULTI
    for (int ph = 0; ph < NPH; ++ph) { p.ph_lo = ph; p.ph_hi = ph + 1; hipLaunchKernelGGL(mega, dim3(grid), dim3(NTHR), LDS_BYTES, stream, p); }
#else
    p.ph_lo = 0; p.ph_hi = NPH; hipLaunchKernelGGL(mega, dim3(grid), dim3(NTHR), LDS_BYTES, stream, p);
#endif
    const hipError_t le = hipPeekAtLastError();
    if (le != hipSuccess) fprintf(stderr, "kernel_launch: launch failed: %s\n", hipGetErrorName(le));
}
```
